# Optimizing an MI355X kernel written in HIP

```python
import math
import jax, jax.numpy as jnp
from jax import lax
import numpy as np

D_MODEL = 1024
BATCH = 16
SEQ = 256
DEPTH = 4
DEC_BATCH = 2
DEC_SEQ = 1024
PAST_LEN = 512

GRID_W = 64
N_EVEN = (DEPTH + 1) // 2
N_ODD = DEPTH // 2
Q_BLOCK = 128
ROPE_THETA = 10000.0
NORM_EPS = 1e-6
DH = 64
A_W = D_MODEL // 2
CONV_K = 31
H_B = D_MODEL // (4 * DH)
B_W = H_B * 2 * DH
H_C = D_MODEL // (2 * DH)
KV_C = H_C // 4
G_C = H_C // KV_C
C_W = H_C * DH
H_D = D_MODEL // (2 * DH)
KV_D = H_D // 4
G_D = H_D // KV_D
D_W = H_D * DH
WINDOW = 128

IN_E = 3 * A_W + 4 * B_W
OUT_E = A_W + B_W
SPLIT_E = [A_W, 2 * A_W, 3 * A_W, 3 * A_W + B_W, 3 * A_W + 2 * B_W, 3 * A_W + 3 * B_W]
IN_O = 2 * C_W + 2 * KV_C * DH + 2 * D_W + 2 * KV_D * DH
OUT_O = C_W + D_W
_o = np.cumsum([C_W, KV_C * DH, KV_C * DH, C_W, D_W, KV_D * DH, KV_D * DH])
SPLIT_O = [int(v) for v in _o]

kernel_name = "hybrid_diffusion_prefix_step"

F32 = jnp.float32


def rms_norm(x, g):
    xf = x.astype(F32)
    y = xf * lax.rsqrt(jnp.mean(xf * xf, axis=-1, keepdims=True) + NORM_EPS)
    return (y * g.astype(F32)).astype(x.dtype)


def layer_norm(x, g, b):
    xf = x.astype(F32)
    mu = jnp.mean(xf, axis=-1, keepdims=True)
    var = jnp.mean(jnp.square(xf - mu), axis=-1, keepdims=True)
    y = (xf - mu) * lax.rsqrt(var + NORM_EPS) * g.astype(F32) + b.astype(F32)
    return y.astype(x.dtype)


def rope_2d(x):
    T, d = x.shape[1], x.shape[-1]
    rows = T // GRID_W
    nf = d // 4
    row = jnp.repeat(jnp.arange(rows), GRID_W).astype(F32)
    col = jnp.tile(jnp.arange(GRID_W), rows).astype(F32)
    inv = ROPE_THETA ** (-jnp.arange(nf, dtype=F32) / nf)
    ang = jnp.stack([row[:, None] * inv, col[:, None] * inv], axis=1)
    ang = ang.reshape((T,) + (1,) * (x.ndim - 3) + (2, nf))
    cos, sin = jnp.cos(ang), jnp.sin(ang)
    xr = x.astype(F32).reshape(x.shape[:-1] + (2, 2, nf))
    x1, x2 = xr[..., 0, :], xr[..., 1, :]
    out = jnp.stack([x1 * cos - x2 * sin, x2 * cos + x1 * sin], axis=-2)
    return out.reshape(x.shape).astype(x.dtype)


def over_query_blocks(fn, q):
    b, T = q.shape[:2]
    nb = T // Q_BLOCK
    qb = jnp.moveaxis(q.reshape((b, nb, Q_BLOCK) + q.shape[2:]), 1, 0)
    ob = lax.map(fn, qb)
    return jnp.moveaxis(ob, 0, 1).reshape((b, T) + ob.shape[3:])


def diff_attend(q, k, v, lam):
    s = jnp.einsum('bqhcd,bkhcd->bhcqk', q, k).astype(F32) * (q.shape[-1] ** -0.5)
    p = jax.nn.softmax(s, axis=-1)
    w = p[:, :, 0] - lam * p[:, :, 1]
    return jnp.einsum('bhqk,bkhv->bqhv', w.astype(v.dtype), v)


def gqa_attend(q, k, v, sink=None):
    s = jnp.einsum('bqngd,bknd->bngqk', q, k).astype(F32) * (q.shape[-1] ** -0.5)
    if sink is None:
        p = jax.nn.softmax(s, axis=-1)
    else:
        sk = jnp.broadcast_to(sink.astype(F32)[None, :, :, None, None], s.shape[:-1] + (1,))
        p = jax.nn.softmax(jnp.concatenate([s, sk], axis=-1), axis=-1)[..., :-1]
    return jnp.einsum('bngqk,bknd->bqngd', p.astype(v.dtype), v)


def banded_sink_attend(q, k, v, ck, cv, sink):
    b, T, N, G, d = q.shape
    nb = T // Q_BLOCK
    L = ck.shape[1]
    scale = d ** -0.5

    def band(a):
        ab = a.reshape(b, nb, Q_BLOCK, N, d)
        ap = jnp.pad(ab, ((0, 0), (1, 1), (0, 0), (0, 0), (0, 0)))
        return jnp.concatenate([ap[:, :-2], ap[:, 1:-1], ap[:, 2:]], axis=2)

    qb = jnp.moveaxis(q.reshape(b, nb, Q_BLOCK, N, G, d), 1, 0)
    kb = jnp.moveaxis(band(k), 1, 0)
    vb = jnp.moveaxis(band(v), 1, 0)
    blk = jnp.arange(nb)[:, None, None]
    qpos = blk * Q_BLOCK + jnp.arange(Q_BLOCK)[None, :, None]
    kpos = (blk - 1) * Q_BLOCK + jnp.arange(3 * Q_BLOCK)[None, None, :]
    valid = (jnp.abs(qpos - kpos) <= WINDOW) & (kpos >= 0) & (kpos < T)

    def one(args):
        qi, ki, vi, mi = args
        s_loc = jnp.einsum('bqngd,bknd->bngqk', qi, ki).astype(F32) * scale
        s_loc = jnp.where(mi[None, None, None], s_loc, -jnp.inf)
        s_ctx = jnp.einsum('bqngd,bknd->bngqk', qi, ck).astype(F32) * scale
        sk = jnp.broadcast_to(sink.astype(F32)[None, :, :, None, None], s_ctx.shape[:-1] + (1,))
        p = jax.nn.softmax(jnp.concatenate([s_ctx, s_loc, sk], axis=-1), axis=-1)
        p_ctx = p[..., :L].astype(v.dtype)
        p_loc = p[..., L:L + 3 * Q_BLOCK].astype(v.dtype)
        return (jnp.einsum('bngqk,bknd->bqngd', p_ctx, cv)
                + jnp.einsum('bngqk,bknd->bqngd', p_loc, vi))

    ob = lax.map(one, (qb, kb, vb, valid))
    return jnp.moveaxis(ob, 0, 1).reshape(b, T, N, G, d)


def even_mix(h, w_in, conv_w, conv_b, ln_g, ln_b, lam_vec, subln_g, w_out, lam_init, ctx_kv):
    b, T, _ = h.shape
    a_u, a_g, a_z, b_q, b_k, b_v, b_z = jnp.split(h @ w_in, SPLIT_E, axis=-1)
    a = a_u * jax.nn.sigmoid(a_g)
    a = lax.conv_general_dilated(a, conv_w[:, None, :].astype(a.dtype), window_strides=(1,),
                                 padding=[(CONV_K // 2, CONV_K // 2)],
                                 dimension_numbers=('NWC', 'WIO', 'NWC'),
                                 feature_group_count=A_W) + conv_b
    a = jax.nn.silu(layer_norm(a, ln_g, ln_b)) * jax.nn.silu(a_z)
    q = b_q.reshape(b, T, H_B, 2, DH)
    k = b_k.reshape(b, T, H_B, 2, DH)
    v = b_v.reshape(b, T, H_B, 2 * DH)
    lv = lam_vec.astype(F32)
    lam = jnp.exp(jnp.sum(lv[0] * lv[1])) - jnp.exp(jnp.sum(lv[2] * lv[3])) + lam_init
    if ctx_kv is None:
        keys, vals, new_kv = k, v, (k, v)
    else:
        q, k = rope_2d(q), rope_2d(k)
        keys = jnp.concatenate([ctx_kv[0], k], axis=1)
        vals = jnp.concatenate([ctx_kv[1], v], axis=1)
        new_kv = None
    o = over_query_blocks(lambda qb: diff_attend(qb, keys, vals, lam), q)
    o = rms_norm(o, subln_g) * (1.0 - lam_init)
    o = o.reshape(b, T, B_W) * jax.nn.silu(b_z)
    return jnp.concatenate([a, o], axis=-1) @ w_out, new_kv


def odd_mix(h, w_in, q_norm, k_norm, sink, w_out, ctx_kv):
    b, T, _ = h.shape
    c_q, c_k, c_v, c_z, d_q, d_k, d_v, d_z = jnp.split(h @ w_in, SPLIT_O, axis=-1)
    cq = rms_norm(c_q.reshape(b, T, KV_C, G_C, DH), q_norm)
    ck = rms_norm(c_k.reshape(b, T, KV_C, DH), k_norm)
    cv = c_v.reshape(b, T, KV_C, DH)
    dq = d_q.reshape(b, T, KV_D, G_D, DH)
    dk = d_k.reshape(b, T, KV_D, DH)
    dv = d_v.reshape(b, T, KV_D, DH)
    sk = sink.reshape(KV_D, G_D)
    if ctx_kv is None:
        oc = over_query_blocks(lambda qb: gqa_attend(qb, ck, cv), cq)
        od = over_query_blocks(lambda qb: gqa_attend(qb, dk, dv, sk), dq)
        new_kv = (ck, cv, dk, dv)
    else:
        cck, ccv, cdk, cdv = ctx_kv
        cq, ck, dq, dk = rope_2d(cq), rope_2d(ck), rope_2d(dq), rope_2d(dk)
        keys = jnp.concatenate([cck, ck], axis=1)
        vals = jnp.concatenate([ccv, cv], axis=1)
        oc = over_query_blocks(lambda qb: gqa_attend(qb, keys, vals), cq)
        od = banded_sink_attend(dq, dk, dv, cdk, cdv, sk)
        new_kv = None
    oc = oc.reshape(b, T, C_W) * jax.nn.silu(c_z)
    od = od.reshape(b, T, D_W) * jax.nn.silu(d_z)
    return jnp.concatenate([oc, od], axis=-1) @ w_out, new_kv


def modulation(cond, w_mod, b_mod):
    m = (jax.nn.silu(cond) @ w_mod + b_mod).reshape(-1, 1, 3 * D_MODEL)
    return jnp.split(m, 3, axis=-1)


def setup_inputs(seed: int = 0) -> dict:
    key = jax.random.key(seed)
    ks = iter(jax.random.split(key, 32))
    nrm = lambda shape, s=1.0: jax.random.normal(next(ks), shape, F32) * s
    return {
        'x_prompt': nrm((BATCH, SEQ, D_MODEL)),
        'x_sample': nrm((DEC_BATCH, DEC_SEQ, D_MODEL)),
        'cache_b_k': nrm((DEC_BATCH, N_EVEN, PAST_LEN, H_B, 2, DH)),
        'cache_b_v': nrm((DEC_BATCH, N_EVEN, PAST_LEN, H_B, 2 * DH)),
        'cache_c_k': nrm((DEC_BATCH, N_ODD, PAST_LEN, KV_C, DH)),
        'cache_c_v': nrm((DEC_BATCH, N_ODD, PAST_LEN, KV_C, DH)),
        'cache_d_k': nrm((DEC_BATCH, N_ODD, PAST_LEN, KV_D, DH)),
        'cache_d_v': nrm((DEC_BATCH, N_ODD, PAST_LEN, KV_D, DH)),
        'c': nrm((DEC_BATCH, D_MODEL)),
        'c_ctx': nrm((D_MODEL,)),
        'norm_pre': 1.0 + nrm((DEPTH, D_MODEL), 0.1),
        'norm_post': 1.0 + nrm((DEPTH, D_MODEL), 0.1),
        'w_mod': nrm((DEPTH, D_MODEL, 3 * D_MODEL), 0.5 * D_MODEL ** -0.5),
        'b_mod': nrm((DEPTH, 3 * D_MODEL), 0.02),
        'w_in_even': nrm((N_EVEN, D_MODEL, IN_E), D_MODEL ** -0.5),
        'a_conv_w': nrm((N_EVEN, CONV_K, A_W), CONV_K ** -0.5),
        'a_conv_b': nrm((N_EVEN, A_W), 0.02),
        'a_ln_g': 1.0 + nrm((N_EVEN, A_W), 0.1),
        'a_ln_b': nrm((N_EVEN, A_W), 0.02),
        'b_lambda': nrm((N_EVEN, 4, DH), 0.1),
        'b_subln_g': 1.0 + nrm((N_EVEN, 2 * DH), 0.1),
        'w_out_even': nrm((N_EVEN, OUT_E, D_MODEL), OUT_E ** -0.5),
        'w_in_odd': nrm((N_ODD, D_MODEL, IN_O), D_MODEL ** -0.5),
        'c_q_norm': 1.0 + nrm((N_ODD, DH), 0.1),
        'c_k_norm': 1.0 + nrm((N_ODD, DH), 0.1),
        'd_sink': nrm((N_ODD, H_D), 0.5),
        'w_out_odd': nrm((N_ODD, OUT_O, D_MODEL), OUT_O ** -0.5),
    }


def reference(x_prompt, x_sample, cache_b_k, cache_b_v, cache_c_k, cache_c_v, cache_d_k, cache_d_v,
              c, c_ctx, norm_pre, norm_post, w_mod, b_mod, w_in_even, a_conv_w, a_conv_b, a_ln_g,
              a_ln_b, b_lambda, b_subln_g, w_out_even, w_in_odd, c_q_norm, c_k_norm, d_sink,
              w_out_odd):
    xp, xs = x_prompt, x_sample
    nbk, nbv, nck, ncv, ndk, ndv = [], [], [], [], [], []
    for l in range(DEPTH):
        i = l // 2
        sh_p, sc_p, g_p = modulation(c_ctx, w_mod[l], b_mod[l])
        sh_s, sc_s, g_s = modulation(c, w_mod[l], b_mod[l])
        hp = rms_norm(xp, norm_pre[l]) * (1.0 + sc_p) + sh_p
        hs = rms_norm(xs, norm_pre[l]) * (1.0 + sc_s) + sh_s
        if l % 2 == 0:
            lam_init = 0.8 - 0.6 * math.exp(-0.3 * l)
            args = (w_in_even[i], a_conv_w[i], a_conv_b[i], a_ln_g[i], a_ln_b[i],
                    b_lambda[i], b_subln_g[i], w_out_even[i], lam_init)
            op, (kp, vp) = even_mix(hp, *args, None)
            os_, _ = even_mix(hs, *args, (cache_b_k[:, i], cache_b_v[:, i]))
            nbk.append(kp)
            nbv.append(vp)
        else:
            args = (w_in_odd[i], c_q_norm[i], c_k_norm[i], d_sink[i], w_out_odd[i])
            op, (ck, cv, dk, dv) = odd_mix(hp, *args, None)
            os_, _ = odd_mix(hs, *args, (cache_c_k[:, i], cache_c_v[:, i],
                                         cache_d_k[:, i], cache_d_v[:, i]))
            nck.append(ck)
            ncv.append(cv)
            ndk.append(dk)
            ndv.append(dv)
        xp = xp + g_p * rms_norm(op, norm_post[l])
        xs = xs + g_s * rms_norm(os_, norm_post[l])
    return (xp, xs, jnp.stack(nbk, axis=1), jnp.stack(nbv, axis=1), jnp.stack(nck, axis=1),
            jnp.stack(ncv, axis=1), jnp.stack(ndk, axis=1), jnp.stack(ndv, axis=1))
```

```cpp
#include <hip/hip_runtime.h>
#include <hip/hip_cooperative_groups.h>
#include <cstdio>
#include <cstdint>
namespace cg = cooperative_groups;

#define DI __device__ __forceinline__
typedef unsigned short bf16_t;
typedef short bf16x8 __attribute__((ext_vector_type(8)));
typedef short s16x4 __attribute__((ext_vector_type(4)));
typedef float f32x16 __attribute__((ext_vector_type(16)));
typedef float f32x4 __attribute__((ext_vector_type(4)));
typedef float f32x2 __attribute__((ext_vector_type(2)));
typedef unsigned u32x4 __attribute__((ext_vector_type(4)));
typedef unsigned u32x2 __attribute__((ext_vector_type(2)));
typedef __bf16 bf2_t __attribute__((ext_vector_type(2)));

DI unsigned pk2(float lo, float hi) { f32x2 v = {lo, hi}; return __builtin_bit_cast(unsigned, __builtin_convertvector(v, bf2_t)); }
DI float bf_lo(unsigned u) { return __uint_as_float(u << 16); }
DI float bf_hi(unsigned u) { return __uint_as_float(u & 0xffff0000u); }
DI f32x16 mfma32(bf16x8 a, bf16x8 b, f32x16 c) { return __builtin_amdgcn_mfma_f32_32x32x16_bf16(a, b, c, 0, 0, 0); }
DI float sigmoidf_(float x) { return __builtin_amdgcn_rcpf(1.0f + __expf(-x)); }
DI int opaque_tid() { int t = threadIdx.x; asm volatile("" : "+v"(t)); return t; }
template <int CTRL> DI float dpp_f(float v) { return __builtin_bit_cast(float, __builtin_amdgcn_update_dpp(0, __builtin_bit_cast(int, v), CTRL, 0xF, 0xF, true)); }
DI float wave_sum(float v) {
  v += dpp_f<0xB1>(v);
  v += dpp_f<0x4E>(v);
  v += dpp_f<0x141>(v);
  v += dpp_f<0x140>(v);
  v += __shfl_xor(v, 16);
  const auto sw = __builtin_amdgcn_permlane32_swap(__float_as_uint(v), __float_as_uint(v), false, false);
  return __uint_as_float(sw[0]) + __uint_as_float(sw[1]);
}

constexpr int NTOK = 6144, NP = 4096;
constexpr float EPS = 1e-6f;
constexpr size_t OFF_NBK = 6291456, OFF_NBV = 10485760, OFF_NCK = 14680064, OFF_NCV = 15728640, OFF_NDK = 16777216, OFF_NDV = 17825792;
constexpr size_t WS_CTR = 0;
constexpr size_t WS_BAR = 1024;
constexpr size_t WS_MOD = 16384;
constexpr size_t WS_WIE = WS_MOD + 147456;
constexpr size_t WS_WOE = WS_WIE + 14680064;
constexpr size_t WS_WIO = WS_WOE + 4194304;
constexpr size_t WS_WOO = WS_WIO + 10485760;
constexpr size_t WS_CBK = WS_WOO + 4194304;
constexpr size_t WS_CBV = WS_CBK + 2097152;
constexpr size_t WS_CCK = WS_CBV + 2097152;
constexpr size_t WS_CCV = WS_CCK + 524288;
constexpr size_t WS_CDK = WS_CCV + 524288;
constexpr size_t WS_CDV = WS_CDK + 524288;
constexpr size_t WS_H = WS_CDV + 524288;
constexpr size_t WS_QKV = WS_H + 12582912;
constexpr size_t WS_VT = WS_QKV + 37748736;
constexpr size_t WS_VTD = WS_VT + 1572864;
constexpr size_t WS_MIX = WS_VT + 6291456;
constexpr size_t WS_O = WS_MIX + 12582912;
constexpr size_t WS_END = WS_O + 25165824;

struct Params {
  const float* in[27];
  float* out;
  unsigned char* ws;
};

constexpr int NPHASE = 18;


#define XB_TMO      128
#define XB_XCNT(j)  (256  + 64 * (j))
#define XB_XSUB(j)  (1280 + 64 * (j))
#define XB_XGEN(j)  (2304 + 64 * (j))
#define XB_TOP      3328
#define XB_TOPGEN   3392
#define XCD_BAR_WORDS 3456
#define XB_SPIN_CAP (1u << 18)
#define LAS __attribute__((address_space(3)))
DI unsigned xb_ld(unsigned* p) { return __hip_atomic_load(p, __ATOMIC_RELAXED, __HIP_MEMORY_SCOPE_AGENT); }
DI unsigned xb_add(unsigned* p, unsigned v) { return __hip_atomic_fetch_add(p, v, __ATOMIC_RELAXED, __HIP_MEMORY_SCOPE_AGENT); }
DI unsigned xb_xcc_id() { return (unsigned)__builtin_amdgcn_s_getreg((3 << 11) | 20) & 0xFu; }
#define XB_SPIN(cond, bar) do { unsigned _sp = 0; while (cond) { __builtin_amdgcn_s_sleep(1); \
    if ((++_sp & 255u) == 0u) { if (xb_ld(&(bar)[XB_TMO])) break; if (_sp > XB_SPIN_CAP) { atomicAdd(&(bar)[XB_TMO], 1u); break; } } } } while (0)
struct XcdBarrier { unsigned* bar; unsigned x; volatile LAS unsigned* st; };
DI XcdBarrier xcd_barrier_post(unsigned* bar, volatile LAS unsigned* st) {
  XcdBarrier b; b.bar = bar; b.x = xb_xcc_id(); b.st = st;
  if (threadIdx.x == 0) (void)xb_add(&bar[XB_XCNT(b.x)], 1u);
  return b;
}
DI void xcd_barrier_complete(unsigned* bar, unsigned x, unsigned& nloc, unsigned& nx) {
  const unsigned G = gridDim.x * gridDim.y * gridDim.z;
  unsigned sum, cnt, mine, sp = 0u;
  for (;;) {
    sum = 0u; cnt = 0u; mine = 0u;
#pragma unroll
    for (unsigned j = 0; j < 16; ++j) { const unsigned c = xb_ld(&bar[XB_XCNT(j)]); sum += c; cnt += (c > 0u) ? 1u : 0u; mine = (j == x) ? c : mine; }
    if (sum == G) break;
    __builtin_amdgcn_s_sleep(1);
    if ((++sp & 255u) == 0u) { if (xb_ld(&bar[XB_TMO])) break; if (sp > XB_SPIN_CAP) { atomicAdd(&bar[XB_TMO], 1u); break; } }
  }
  nloc = mine > 0u ? mine : 1u; nx = cnt > 0u ? cnt : 1u;
}
DI void xcd_barrier(const XcdBarrier& b) {
  asm volatile("s_waitcnt vmcnt(0)" ::: "memory");
  __syncthreads();
  if (threadIdx.x == 0) {
    unsigned* bar = b.bar;
    __builtin_amdgcn_s_waitcnt(0);
    unsigned nloc = b.st[0], nx = b.st[1];
    if (nloc == 0u) { xcd_barrier_complete(bar, b.x, nloc, nx); b.st[0] = nloc; b.st[1] = nx; }
    const unsigned old = xb_add(&bar[XB_XSUB(b.x)], 1u);
    const unsigned gen = old / nloc;
    if (old + 1u == (gen + 1u) * nloc) {
      __builtin_amdgcn_fence(__ATOMIC_RELEASE, "agent");
      asm volatile("s_waitcnt vmcnt(0)" ::: "memory");
      const unsigned og = xb_add(&bar[XB_TOP], 1u);
      const unsigned tg = og / nx;
      if (og + 1u == (tg + 1u) * nx) xb_add(&bar[XB_TOPGEN], 1u);
      else XB_SPIN(xb_ld(&bar[XB_TOPGEN]) == tg, bar);
      __builtin_amdgcn_fence(__ATOMIC_ACQUIRE, "agent");
      xb_add(&bar[XB_XGEN(b.x)], 1u);
      asm volatile("s_waitcnt vmcnt(0)" ::: "memory");
    } else {
      XB_SPIN(xb_ld(&bar[XB_XGEN(b.x)]) == gen, bar);
      __builtin_amdgcn_fence(__ATOMIC_ACQUIRE, "agent");
      asm volatile("s_waitcnt vmcnt(0)" ::: "memory");
    }
  }
  __syncthreads();
}

template <bool PERMK>
DI void trans_tile(const float* __restrict__ src, int sstride, bf16_t* __restrict__ dst, int dstride, unsigned char* lds) {
  bf16_t* T = (bf16_t*)lds;
  const int tid = opaque_tid();
  __syncthreads();
#pragma unroll
  for (int ps = 0; ps < 4; ++ps) {
    const int ksrc = (tid >> 4) + 16 * ps, nn = (tid & 15) * 4;
    const int kk = PERMK ? ((ksrc & ~12) | ((ksrc & 4) << 1) | ((ksrc & 8) >> 1)) : ksrc;
    const f32x4 v = *(const f32x4*)(src + (size_t)ksrc * sstride + nn);
    const unsigned a = pk2(v[0], v[1]), b = pk2(v[2], v[3]);
    T[(nn + 0) * 66 + kk] = (bf16_t)(a & 0xffffu);
    T[(nn + 1) * 66 + kk] = (bf16_t)(a >> 16);
    T[(nn + 2) * 66 + kk] = (bf16_t)(b & 0xffffu);
    T[(nn + 3) * 66 + kk] = (bf16_t)(b >> 16);
  }
  __syncthreads();
  const int n = tid >> 2, ch = tid & 3;
  const unsigned* Tr = (const unsigned*)(T + n * 66 + ch * 16);
  u32x4 o0 = {Tr[0], Tr[1], Tr[2], Tr[3]}, o1 = {Tr[4], Tr[5], Tr[6], Tr[7]};
  u32x4* d = (u32x4*)(dst + (size_t)n * dstride + ch * 16);
  d[0] = o0; d[1] = o1;
}

DI void conv_tile4096(const float* __restrict__ src, bf16_t* __restrict__ dst) {
  const int tid = opaque_tid();
#pragma unroll
  for (int ps = 0; ps < 4; ++ps) {
    const int e = ps * 1024 + tid * 4;
    const f32x4 v = *(const f32x4*)(src + e);
    u32x2 o = {pk2(v[0], v[1]), pk2(v[2], v[3])};
    *(u32x2*)(dst + e) = o;
  }
}

DI void mod_tile(const Params& p, int t, unsigned char* lds) {
  const int l = t / 96, grp = t % 96;
  float* sc = (float*)lds;
  float* red = (float*)(lds + 12288);
  const int tid = opaque_tid();
  __syncthreads();
  for (int idx = tid; idx < 3072; idx += 256) {
    const int r = idx >> 10, k = idx & 1023;
    const float c = (r == 0) ? p.in[9][k] : p.in[8][(r - 1) * 1024 + k];
    sc[idx] = c / (1.0f + expf(-c));
  }
  __syncthreads();
  const int cg4 = tid & 7, kr = tid >> 3;
  const float* W = p.in[12] + (size_t)l * 1024 * 3072 + grp * 32 + cg4 * 4;
  f32x4 a0 = {0, 0, 0, 0}, a1 = {0, 0, 0, 0}, a2 = {0, 0, 0, 0};
#pragma unroll 8
  for (int ps = 0; ps < 32; ++ps) {
    const int k = kr + 32 * ps;
    const f32x4 wv = *(const f32x4*)(W + (size_t)k * 3072);
    a0 += sc[k] * wv; a1 += sc[1024 + k] * wv; a2 += sc[2048 + k] * wv;
  }
  float* rp = red + (kr * 8 + cg4) * 12;
  *(f32x4*)(rp) = a0; *(f32x4*)(rp + 4) = a1; *(f32x4*)(rp + 8) = a2;
  __syncthreads();
  if (tid < 96) {
    const int r = tid >> 5, c = tid & 31;
    float s = 0.f;
    for (int k2 = 0; k2 < 32; ++k2) s += red[(k2 * 8 + (c >> 2)) * 12 + r * 4 + (c & 3)];
    float* mod = (float*)(p.ws + WS_MOD);
    mod[(l * 3 + r) * 3072 + grp * 32 + c] = s + p.in[13][l * 3072 + grp * 32 + c];
  }
}

DI void wdesc(const Params& p, int u, const float*& src, int& ss, bf16_t*& dst) {
  if (u < 1792) {
    const int i = u / 896, v = u % 896, kt = v & 15, dt = v >> 4;
    const int sb = dt < 16 ? ((dt & 1) ? 8 + (dt >> 1) : (dt >> 1)) : dt;
    src = p.in[14] + (size_t)i * 1024 * 3584 + (size_t)kt * 64 * 3584 + sb * 64; ss = 3584;
    dst = (bf16_t*)(p.ws + WS_WIE) + (size_t)i * 3584 * 1024 + (size_t)dt * 64 * 1024 + kt * 64;
  } else if (u < 2304) {
    u -= 1792; const int i = u >> 8, v = u & 255, kt = v & 15, dt = v >> 4;
    src = p.in[21] + (size_t)i * 1024 * 1024 + (size_t)kt * 64 * 1024 + dt * 64; ss = 1024;
    dst = (bf16_t*)(p.ws + WS_WOE) + (size_t)i * 1024 * 1024 + (size_t)dt * 64 * 1024 + kt * 64;
  } else if (u < 3584) {
    u -= 2304; const int i = u / 640, v = u % 640, kt = v & 15, dt = v >> 4;
    src = p.in[22] + (size_t)i * 1024 * 2560 + (size_t)kt * 64 * 2560 + dt * 64; ss = 2560;
    dst = (bf16_t*)(p.ws + WS_WIO) + (size_t)i * 2560 * 1024 + (size_t)dt * 64 * 1024 + kt * 64;
  } else {
    u -= 3584; const int i = u >> 8, v = u & 255, kt = v & 15, dt = v >> 4;
    src = p.in[26] + (size_t)i * 1024 * 1024 + (size_t)kt * 64 * 1024 + dt * 64; ss = 1024;
    dst = (bf16_t*)(p.ws + WS_WOO) + (size_t)i * 1024 * 1024 + (size_t)dt * 64 * 1024 + kt * 64;
  }
}
DI void phase_prep(const Params& p, unsigned char* lds) {
  const int tid = opaque_tid();
  for (int t = blockIdx.x; t < 384; t += gridDim.x) mod_tile(p, t, lds);
  {
    bf16_t* T = (bf16_t*)lds;
    f32x4 cur[4], nxt[4];
    const float* src; int ss; bf16_t* dst;
    int u = blockIdx.x;
    if (u < 4096) {
      wdesc(p, u, src, ss, dst);
#pragma unroll
      for (int ps = 0; ps < 4; ++ps) cur[ps] = *(const f32x4*)(src + (size_t)((tid >> 4) + 16 * ps) * ss + (tid & 15) * 4);
    }
    while (u < 4096) {
      const int un = u + gridDim.x;
      bf16_t* dcur = dst;
      if (un < 4096) {
        wdesc(p, un, src, ss, dst);
#pragma unroll
        for (int ps = 0; ps < 4; ++ps) nxt[ps] = *(const f32x4*)(src + (size_t)((tid >> 4) + 16 * ps) * ss + (tid & 15) * 4);
      }
      __builtin_amdgcn_sched_barrier(0);
      __syncthreads();
#pragma unroll
      for (int ps = 0; ps < 4; ++ps) {
        const int kk = (tid >> 4) + 16 * ps, nn = (tid & 15) * 4;
        const unsigned a = pk2(cur[ps][0], cur[ps][1]), b2 = pk2(cur[ps][2], cur[ps][3]);
        T[(nn + 0) * 66 + kk] = (bf16_t)(a & 0xffffu);
        T[(nn + 1) * 66 + kk] = (bf16_t)(a >> 16);
        T[(nn + 2) * 66 + kk] = (bf16_t)(b2 & 0xffffu);
        T[(nn + 3) * 66 + kk] = (bf16_t)(b2 >> 16);
      }
      __syncthreads();
      {
        const int n = tid >> 2, ch = tid & 3;
        const unsigned* Tr = (const unsigned*)(T + n * 66 + ch * 16);
        u32x4 o0 = {Tr[0], Tr[1], Tr[2], Tr[3]}, o1 = {Tr[4], Tr[5], Tr[6], Tr[7]};
        u32x4* d = (u32x4*)(dcur + (size_t)n * 1024 + ch * 16);
        d[0] = o0; d[1] = o1;
      }
#pragma unroll
      for (int ps = 0; ps < 4; ++ps) cur[ps] = nxt[ps];
      u = un;
    }
  }
  for (int t = 4480 + blockIdx.x; t < 5248; t += gridDim.x) {
    if (t < 4864) {
      int u = t - 4480;
      if (u < 256) {
        const int bi = u >> 6, v = u & 63, kt = v & 7, ct = v >> 3;
        trans_tile<true>(p.in[3] + ((size_t)bi * 512 + kt * 64) * 512 + ct * 64, 512,
                   (bf16_t*)(p.ws + WS_CBV) + ((size_t)bi * 512 + ct * 64) * 512 + kt * 64, 512, lds);
      } else {
        const bool isd = u >= 320; u -= isd ? 320 : 256;
        const int bi = u >> 4, v = u & 15, kt = v & 7, ct = v >> 3;
        trans_tile<true>(p.in[isd ? 7 : 5] + ((size_t)bi * 512 + kt * 64) * 128 + ct * 64, 128,
                   (bf16_t*)(p.ws + (isd ? WS_CDV : WS_CCV)) + ((size_t)bi * 128 + ct * 64) * 512 + kt * 64, 512, lds);
      }
    } else {
      int u = t - 4864;
      if (u < 256) conv_tile4096(p.in[2] + (size_t)u * 4096, (bf16_t*)(p.ws + WS_CBK) + (size_t)u * 4096);
      else if (u < 320) conv_tile4096(p.in[4] + (size_t)(u - 256) * 4096, (bf16_t*)(p.ws + WS_CCK) + (size_t)(u - 256) * 4096);
      else conv_tile4096(p.in[6] + (size_t)(u - 320) * 4096, (bf16_t*)(p.ws + WS_CDK) + (size_t)(u - 320) * 4096);
    }
  }
}

DI void phase_post(const Params& p, int ldone, int lnext) {
  const int tid = opaque_tid(); const int lane = tid & 63, w = tid >> 6;
  const float* mod = (const float*)(p.ws + WS_MOD);
  const bf16_t* O = (const bf16_t*)(p.ws + WS_O);
  bf16_t* H = (bf16_t*)(p.ws + WS_H);
  for (int row = blockIdx.x * 4 + w; row < NTOK; row += gridDim.x * 4) {
    const int r = row < NP ? 0 : 1 + ((row - NP) >> 10);
    const float* xin = (ldone <= 0) ? (row < NP ? p.in[0] + (size_t)row * 1024 : p.in[1] + (size_t)(row - NP) * 1024) : p.out + (size_t)row * 1024;
    f32x4 x[4], gv[4], nv[4], shv[4], scv[4], npv[4]; u32x2 ov[4];
#pragma unroll
    for (int j = 0; j < 4; ++j) x[j] = *(const f32x4*)(xin + lane * 4 + 256 * j);
    if (ldone >= 0) {
      const float* g = mod + (size_t)(ldone * 3 + r) * 3072 + 2048;
      const float* np_ = p.in[11] + ldone * 1024;
#pragma unroll
      for (int j = 0; j < 4; ++j) { ov[j] = *(const u32x2*)(O + (size_t)row * 1024 + lane * 4 + 256 * j); gv[j] = *(const f32x4*)(g + lane * 4 + 256 * j); nv[j] = *(const f32x4*)(np_ + lane * 4 + 256 * j); }
    }
    if (lnext < 4) {
      const float* sh = mod + (size_t)(lnext * 3 + r) * 3072;
      const float* npre = p.in[10] + lnext * 1024;
#pragma unroll
      for (int j = 0; j < 4; ++j) { const int c = lane * 4 + 256 * j; shv[j] = *(const f32x4*)(sh + c); scv[j] = *(const f32x4*)(sh + 1024 + c); npv[j] = *(const f32x4*)(npre + c); }
    }
    __builtin_amdgcn_sched_barrier(0);
    if (ldone >= 0) {
      f32x4 o[4]; float ss = 0.f;
#pragma unroll
      for (int j = 0; j < 4; ++j) { o[j] = (f32x4){bf_lo(ov[j][0]), bf_hi(ov[j][0]), bf_lo(ov[j][1]), bf_hi(ov[j][1])}; ss += o[j][0] * o[j][0] + o[j][1] * o[j][1] + o[j][2] * o[j][2] + o[j][3] * o[j][3]; }
      ss = wave_sum(ss);
      const float rs = rsqrtf(ss * (1.0f / 1024.0f) + EPS);
#pragma unroll
      for (int j = 0; j < 4; ++j) {
        x[j] = x[j] + gv[j] * (o[j] * rs * nv[j]);
        *(f32x4*)(p.out + (size_t)row * 1024 + lane * 4 + 256 * j) = x[j];
      }
    }
    if (lnext < 4) {
      float ss = 0.f;
#pragma unroll
      for (int j = 0; j < 4; ++j) ss += x[j][0] * x[j][0] + x[j][1] * x[j][1] + x[j][2] * x[j][2] + x[j][3] * x[j][3];
      ss = wave_sum(ss);
      const float rs = rsqrtf(ss * (1.0f / 1024.0f) + EPS);
#pragma unroll
      for (int j = 0; j < 4; ++j) {
        const int c = lane * 4 + 256 * j;
        const f32x4 hv = x[j] * rs * npv[j] * (1.0f + scv[j]) + shv[j];
        u32x2 o2 = {pk2(hv[0], hv[1]), pk2(hv[2], hv[3])};
        *(u32x2*)(H + (size_t)row * 1024 + c) = o2;
      }
    }
  }
}

DI void gemm_core(const bf16_t* __restrict__ A, const bf16_t* __restrict__ B, int K, f32x16 (&acc)[2][2], unsigned char* lds) {
  const int tid = opaque_tid(), lane = tid & 63, w = tid >> 6, wr = w >> 1, wc = w & 1, r31 = lane & 31, hh = lane >> 5;
  u32x4 ra[4], rb[4];
#pragma unroll
  for (int mi = 0; mi < 2; ++mi)
#pragma unroll
    for (int ni = 0; ni < 2; ++ni)
#pragma unroll
      for (int i = 0; i < 16; ++i) acc[mi][ni][i] = 0.f;
  __syncthreads();
#pragma unroll
  for (int i = 0; i < 4; ++i) {
    const int c = tid + 256 * i, row = c >> 3, ch = c & 7;
    ra[i] = *(const u32x4*)(A + (size_t)row * K + ch * 8);
    rb[i] = *(const u32x4*)(B + (size_t)row * K + ch * 8);
  }
#pragma unroll
  for (int i = 0; i < 4; ++i) {
    const int c = tid + 256 * i, row = c >> 3, ch = c & 7, off = row * 128 + ((ch ^ ((row >> 1) & 7)) << 4);
    *(u32x4*)(lds + off) = ra[i]; *(u32x4*)(lds + 16384 + off) = rb[i];
  }
  __syncthreads();
  const int nk = K >> 6;
  for (int kt = 0; kt < nk; ++kt) {
    if (kt + 1 < nk) {
#pragma unroll
      for (int i = 0; i < 4; ++i) {
        const int c = tid + 256 * i, row = c >> 3, ch = c & 7;
        ra[i] = *(const u32x4*)(A + (size_t)row * K + (kt + 1) * 64 + ch * 8);
        rb[i] = *(const u32x4*)(B + (size_t)row * K + (kt + 1) * 64 + ch * 8);
      }
    }
    __builtin_amdgcn_sched_barrier(0);
    const unsigned char* sa = lds + (kt & 1) * 32768 + (wr * 64 + r31) * 128;
    const unsigned char* sb = lds + (kt & 1) * 32768 + 16384 + (wc * 64 + r31) * 128;
    const int sx = (r31 >> 1) & 7;
    bf16x8 af[2][2], bfr[2][2];
#pragma unroll
    for (int mi = 0; mi < 2; ++mi) af[0][mi] = *(const bf16x8*)(sa + mi * 4096 + ((hh ^ sx) << 4));
#pragma unroll
    for (int ni = 0; ni < 2; ++ni) bfr[0][ni] = *(const bf16x8*)(sb + ni * 4096 + ((hh ^ sx) << 4));
#pragma unroll
    for (int ks = 0; ks < 4; ++ks) {
      if (ks < 3) {
        const int sw = (((ks + 1) * 2 + hh) ^ sx) << 4;
#pragma unroll
        for (int mi = 0; mi < 2; ++mi) af[(ks + 1) & 1][mi] = *(const bf16x8*)(sa + mi * 4096 + sw);
#pragma unroll
        for (int ni = 0; ni < 2; ++ni) bfr[(ks + 1) & 1][ni] = *(const bf16x8*)(sb + ni * 4096 + sw);
      }
      __builtin_amdgcn_sched_barrier(0);
#pragma unroll
      for (int mi = 0; mi < 2; ++mi)
#pragma unroll
        for (int ni = 0; ni < 2; ++ni) acc[mi][ni] = mfma32(af[ks & 1][mi], bfr[ks & 1][ni], acc[mi][ni]);
      __builtin_amdgcn_sched_barrier(0);
    }
    if (kt + 1 < nk) {
      unsigned char* da = lds + ((kt + 1) & 1) * 32768;
#pragma unroll
      for (int i = 0; i < 4; ++i) {
        const int c = tid + 256 * i, row = c >> 3, ch = c & 7, off = row * 128 + ((ch ^ ((row >> 1) & 7)) << 4);
        *(u32x4*)(da + off) = ra[i]; *(u32x4*)(da + 16384 + off) = rb[i];
      }
    }
    __syncthreads();
  }
}

__device__ const float INVF[16] = {1.0f, 0.5623413252f, 0.3162277660f, 0.1778279410f, 0.1f, 0.05623413252f, 0.03162277660f, 0.01778279410f,
                                   0.01f, 0.005623413252f, 0.003162277660f, 0.001778279410f, 0.001f, 0.0005623413252f, 0.0003162277660f, 0.0001778279410f};

DI void gemm_in_tile(const Params& p, int l, int tile, unsigned char* lds) {
  const int tid = opaque_tid(), lane = tid & 63, w = tid >> 6, wr = w >> 1, wc = w & 1, r31 = lane & 31, hh = lane >> 5;
  const bool odd = l & 1; const int li = l >> 1;
  const int NTL = odd ? 20 : 28;
  const int mt = tile / NTL, nt = tile % NTL;
  const bool samp = mt >= 32;
  const bf16_t* A = (const bf16_t*)(p.ws + WS_H) + (size_t)mt * 128 * 1024;
  const bf16_t* B = (const bf16_t*)(p.ws + (odd ? WS_WIO : WS_WIE)) + (size_t)li * (odd ? 2560 : 3584) * 1024 + (size_t)nt * 128 * 1024;
  f32x16 acc[2][2];
  gemm_core(A, B, 1024, acc, lds);

  float* stage = (float*)lds;
  bf16_t* qkv = (bf16_t*)(p.ws + WS_QKV);
  int type = 0; bool do_silu = false, do_rope = false; const float* gnorm = nullptr; float* f32out = nullptr; int W = 128; int outcol = 0; int qstride;
  bf16_t* vtbase = nullptr; int ncv = 128, vcol0 = 0;
  if (!odd) {
    qstride = 3072;
    if (nt < 8) { type = 1; outcol = nt * 64; }
    else if (nt < 12) { do_silu = true; outcol = 512 + (nt - 8) * 128; }
    else if (nt < 16) { do_rope = samp; outcol = 1024 + (nt - 12) * 128; }
    else if (nt < 20) { do_rope = samp; outcol = 1536 + (nt - 16) * 128; W = 512; f32out = p.out + OFF_NBK + (size_t)li * 256 * 512 + (nt - 16) * 128; }
    else if (nt < 24) { type = 2; vtbase = (bf16_t*)(p.ws + WS_VT); ncv = 512; vcol0 = (nt - 20) * 128; W = 512; f32out = p.out + OFF_NBV + (size_t)li * 256 * 512 + (nt - 20) * 128; }
    else { do_silu = true; outcol = 2560 + (nt - 24) * 128; }
  } else {
    qstride = 2560; outcol = nt * 128;
    if (nt < 4) { gnorm = p.in[23] + li * 64; do_rope = samp; }
    else if (nt == 4) { gnorm = p.in[24] + li * 64; do_rope = samp; f32out = p.out + OFF_NCK + (size_t)li * 256 * 128; }
    else if (nt == 5) { type = 2; vtbase = (bf16_t*)(p.ws + WS_VT); f32out = p.out + OFF_NCV + (size_t)li * 256 * 128; }
    else if (nt < 10) { do_silu = true; }
    else if (nt < 14) { do_rope = samp; }
    else if (nt == 14) { do_rope = samp; f32out = p.out + OFF_NDK + (size_t)li * 256 * 128; }
    else if (nt == 15) { type = 2; vtbase = (bf16_t*)(p.ws + WS_VTD); f32out = p.out + OFF_NDV + (size_t)li * 256 * 128; }
    else { do_silu = true; }
  }
  if (samp) f32out = nullptr;

#pragma unroll 1
  for (int half = 0; half < 2; ++half) {
    __syncthreads();
    if (wr == half) {
#pragma unroll
      for (int mi = 0; mi < 2; ++mi)
#pragma unroll
        for (int ni = 0; ni < 2; ++ni)
#pragma unroll
          for (int i = 0; i < 16; ++i)
            stage[(mi * 32 + (i & 3) + 8 * (i >> 2) + 4 * hh) * 132 + wc * 64 + ni * 32 + r31] = acc[mi][ni][i];
    }
    __syncthreads();
    const int tokbase = mt * 128 + half * 64;
    const int row = tid >> 2, cc = tid & 3, tok = tokbase + row;
    if (type == 1) {
      float u[16], g[16];
#pragma unroll
      for (int j = 0; j < 4; ++j) {
        const f32x4 a = *(const f32x4*)(stage + row * 132 + cc * 16 + j * 4), b = *(const f32x4*)(stage + row * 132 + 64 + cc * 16 + j * 4);
#pragma unroll
        for (int e = 0; e < 4; ++e) { u[j * 4 + e] = a[e]; g[j * 4 + e] = b[e]; }
      }
      unsigned o[8];
#pragma unroll
      for (int j = 0; j < 8; ++j) o[j] = pk2(u[2 * j] * sigmoidf_(g[2 * j]), u[2 * j + 1] * sigmoidf_(g[2 * j + 1]));
      u32x4* d = (u32x4*)(qkv + (size_t)tok * 3072 + outcol + cc * 16);
      d[0] = (u32x4){o[0], o[1], o[2], o[3]}; d[1] = (u32x4){o[4], o[5], o[6], o[7]};
    } else {
      if (type == 0 || f32out) {
        float v[32];
#pragma unroll
        for (int j = 0; j < 8; ++j) {
          const f32x4 a = *(const f32x4*)(stage + row * 132 + cc * 32 + j * 4);
#pragma unroll
          for (int e = 0; e < 4; ++e) v[j * 4 + e] = a[e];
        }
        if (gnorm) {
          float ss = 0.f;
#pragma unroll
          for (int j = 0; j < 32; ++j) ss += v[j] * v[j];
          ss += __shfl_xor(ss, 1);
          const float rs = rsqrtf(ss * (1.0f / 64.0f) + EPS);
          const float* g = gnorm + (cc & 1) * 32;
#pragma unroll
          for (int j = 0; j < 32; ++j) v[j] *= rs * g[j];
        }
        if (f32out) {
          const int b = tok >> 8, s = tok & 255;
          float* o = f32out + ((size_t)b * 512 + s) * W + cc * 32;
#pragma unroll
          for (int j = 0; j < 8; ++j) *(f32x4*)(o + j * 4) = (f32x4){v[j * 4], v[j * 4 + 1], v[j * 4 + 2], v[j * 4 + 3]};
        }
        if (type == 0) {
          if (do_rope) {
            const int s = (tok - NP) & 1023;
            const float pos = (float)((cc & 1) ? (s & 63) : (s >> 6));
#pragma unroll
            for (int f = 0; f < 16; ++f) {
              const float ang = pos * INVF[f];
              const float sn = __sinf(ang), cs = __cosf(ang);
              const float x1 = v[f], x2 = v[16 + f];
              v[f] = x1 * cs - x2 * sn; v[16 + f] = x2 * cs + x1 * sn;
            }
          }
          if (do_silu) {
#pragma unroll
            for (int j = 0; j < 32; ++j) v[j] = v[j] * sigmoidf_(v[j]);
          }
          u32x4* d = (u32x4*)(qkv + (size_t)tok * qstride + outcol + cc * 32);
#pragma unroll
          for (int j = 0; j < 4; ++j) d[j] = (u32x4){pk2(v[j * 8], v[j * 8 + 1]), pk2(v[j * 8 + 2], v[j * 8 + 3]), pk2(v[j * 8 + 4], v[j * 8 + 5]), pk2(v[j * 8 + 6], v[j * 8 + 7])};
        }
      }
      if (type == 2) {
        const int c = tid & 127, rg = tid >> 7;
        unsigned o[16];
#pragma unroll
        for (int j = 0; j < 16; ++j) o[j] = pk2(stage[(rg * 32 + 2 * j) * 132 + c], stage[(rg * 32 + 2 * j + 1) * 132 + c]);
        const int t0 = tokbase + rg * 32;
        size_t idx;
        if (!samp) { const int b = t0 >> 8, s0 = t0 & 255; idx = ((size_t)b * ncv + vcol0 + c) * 256 + s0; }
        else { const int ts = t0 - NP, b = ts >> 10, s0 = ts & 1023; idx = (size_t)NP * ncv + ((size_t)b * ncv + vcol0 + c) * 1024 + s0; }
        u32x4* d = (u32x4*)(vtbase + idx);
#pragma unroll
        for (int j = 0; j < 4; ++j) {
          const int q0 = 4 * j;
          d[j] = (u32x4){o[(q0 & ~6) | ((q0 & 2) << 1) | ((q0 & 4) >> 1)], o[((q0 + 1) & ~6) | (((q0 + 1) & 2) << 1) | (((q0 + 1) & 4) >> 1)],
                         o[((q0 + 2) & ~6) | (((q0 + 2) & 2) << 1) | (((q0 + 2) & 4) >> 1)], o[((q0 + 3) & ~6) | (((q0 + 3) & 2) << 1) | (((q0 + 3) & 4) >> 1)]};
        }
      }
    }
  }
}

DI void gemm_out_tile(const Params& p, int l, int tile, unsigned char* lds) {
  const int tid = opaque_tid(), lane = tid & 63, w = tid >> 6, wr = w >> 1, wc = w & 1, r31 = lane & 31, hh = lane >> 5;
  const bool odd = l & 1; const int li = l >> 1;
  const int mt = tile >> 3, nt = tile & 7;
  const bf16_t* A = (const bf16_t*)(p.ws + WS_MIX) + (size_t)mt * 128 * 1024;
  const bf16_t* B = (const bf16_t*)(p.ws + (odd ? WS_WOO : WS_WOE)) + (size_t)li * 1024 * 1024 + (size_t)nt * 128 * 1024;
  f32x16 acc[2][2];
  gemm_core(A, B, 1024, acc, lds);
  float* stage = (float*)lds;
  bf16_t* O = (bf16_t*)(p.ws + WS_O);
#pragma unroll 1
  for (int half = 0; half < 2; ++half) {
    __syncthreads();
    if (wr == half) {
#pragma unroll
      for (int mi = 0; mi < 2; ++mi)
#pragma unroll
        for (int ni = 0; ni < 2; ++ni)
#pragma unroll
          for (int i = 0; i < 16; ++i)
            stage[(mi * 32 + (i & 3) + 8 * (i >> 2) + 4 * hh) * 132 + wc * 64 + ni * 32 + r31] = acc[mi][ni][i];
    }
    __syncthreads();
    const int row = tid >> 2, cc = tid & 3;
    float v[32];
#pragma unroll
    for (int j = 0; j < 8; ++j) {
      const f32x4 a = *(const f32x4*)(stage + row * 132 + cc * 32 + j * 4);
#pragma unroll
      for (int e = 0; e < 4; ++e) v[j * 4 + e] = a[e];
    }
    u32x4* d = (u32x4*)(O + (size_t)(mt * 128 + half * 64 + row) * 1024 + nt * 128 + cc * 32);
#pragma unroll
    for (int j = 0; j < 4; ++j) d[j] = (u32x4){pk2(v[j * 8], v[j * 8 + 1]), pk2(v[j * 8 + 2], v[j * 8 + 3]), pk2(v[j * 8 + 4], v[j * 8 + 5]), pk2(v[j * 8 + 6], v[j * 8 + 7])};
  }
}

template <int MODE, int KS>
DI void attn_task(const Params& p, int l, int kind, int b, int head, int qt, int sub, int rotn, int rotd, unsigned char* lds) {
  constexpr int NKC = MODE == 0 ? 2 : 1;
  constexpr int DV = MODE == 0 ? 128 : 64;
  constexpr int NT = DV / 32;
  constexpr int NKT = KS ? 1 : 2;
  constexpr int NG = KS ? 2 : 4;
  constexpr int KCH = NKC * 2;
  constexpr int VCH = DV / 32;
  constexpr int VOFF = NKC * 8192;
  constexpr int STAGE = VOFF + DV * 128;
  constexpr float SC = 0.18033688011112042f;
  constexpr float DEFER_RAW = 8.0f / SC;
  const int tid = opaque_tid(), lane = tid & 63, w = tid >> 6, r31 = lane & 31, hh = lane >> 5;
  const int kh = KS ? (w & 1) : 0;
  const int hq = (MODE == 1) ? (KS ? head * 4 + sub * 2 + (w >> 1) : head * 4 + w) : 0;
  const int li = l >> 1;
  const bf16_t* qkv = (const bf16_t*)(p.ws + WS_QKV);
  bf16_t* mix = (bf16_t*)(p.ws + WS_MIX);
  bool samp, isD = false; int q0, tok0, T;
  const bf16_t *k0p = nullptr, *k1p, *v0p = nullptr, *v1p; int ks0 = 0, ks1, vs0 = 0, vs1;
  int nt0 = 0, t1lo = 0, t1hi; bool windowed = false, has_sink = false; float sinkv = 0.f;
  if (MODE == 0) {
    samp = (kind == 0);
    q0 = qt * (KS ? 32 : 64);
    if (samp) { tok0 = NP + b * 1024; T = 1024; } else { tok0 = b * 256; T = 256; }
    k1p = qkv + (size_t)tok0 * 3072 + 1536 + head * 128; ks1 = 3072;
    const bf16_t* vt = (const bf16_t*)(p.ws + WS_VT);
    v1p = vt + (samp ? (size_t)NP * 512 + ((size_t)b * 512 + head * 128) * 1024 : ((size_t)b * 512 + head * 128) * 256); vs1 = T;
    t1hi = T >> 6;
    if (samp) {
      nt0 = 8;
      k0p = (const bf16_t*)(p.ws + WS_CBK) + ((size_t)(b * 2 + li) * 512) * 512 + head * 128; ks0 = 512;
      v0p = (const bf16_t*)(p.ws + WS_CBV) + ((size_t)(b * 2 + li) * 512 + head * 128) * 512; vs0 = 512;
    }
  } else {
    isD = kind & 1; samp = kind < 2;
    q0 = qt * 32;
    if (samp) { tok0 = NP + b * 1024; T = 1024; } else { tok0 = b * 256; T = 256; }
    k1p = qkv + (size_t)tok0 * 2560 + (isD ? 1792 : 512) + head * 64; ks1 = 2560;
    const bf16_t* vt = (const bf16_t*)(p.ws + (isD ? WS_VTD : WS_VT));
    v1p = vt + (samp ? (size_t)NP * 128 + ((size_t)b * 128 + head * 64) * 1024 : ((size_t)b * 128 + head * 64) * 256); vs1 = T;
    t1hi = T >> 6;
    if (samp) {
      nt0 = 8;
      k0p = (const bf16_t*)(p.ws + (isD ? WS_CDK : WS_CCK)) + ((size_t)(b * 2 + li) * 512) * 128 + head * 64; ks0 = 128;
      v0p = (const bf16_t*)(p.ws + (isD ? WS_CDV : WS_CCV)) + ((size_t)(b * 2 + li) * 128 + head * 64) * 512; vs0 = 512;
    }
    if (isD) {
      has_sink = true; sinkv = p.in[25][li * 8 + hq];
      if (samp) { windowed = true; const int lo = q0 - 128, hi = q0 + 159; t1lo = (lo < 0 ? 0 : lo) >> 6; t1hi = ((hi > 1023 ? 1023 : hi) >> 6) + 1; }
    }
  }
  const int qrow = (MODE == 0 && !KS) ? q0 + 32 * (w & 1) + r31 : q0 + r31;
  const bf16_t* qp = (MODE == 0) ? qkv + (size_t)(tok0 + qrow) * 3072 + 1024 + head * 128 + (w >> 1) * 64
                                 : qkv + (size_t)(tok0 + qrow) * 2560 + (isD ? 1280 : 0) + hq * 64;
  bf16x8 qf[4];
#pragma unroll
  for (int ks = 0; ks < 4; ++ks) qf[ks] = *(const bf16x8*)(qp + ks * 16 + hh * 8);
  const int koff = (MODE == 0) ? (w >> 1) * 8192 : 0;
  const int nst = nt0 + (t1hi - t1lo);
  const int rot = (rotn * nst) / rotd;
  const int swz = (r31 >> 1) & 7;

  typedef __attribute__((address_space(3))) unsigned lds_u32_t;
  typedef __attribute__((address_space(1))) const unsigned glb_u32_t;
  auto dma = [&](int i, int buf) {
    int st = i + rot; if (st >= nst) st -= nst;
    const bf16_t* kp; int kst; const bf16_t* vp; int vst; int key0;
    if (st < nt0) { kp = k0p; kst = ks0; vp = v0p; vst = vs0; key0 = st * 64; }
    else { kp = k1p; kst = ks1; vp = v1p; vst = vs1; key0 = (t1lo + st - nt0) * 64; }
    unsigned char* base = lds + buf * STAGE;
#pragma unroll
    for (int j = 0; j < KCH; ++j) {
      const int q = tid + 256 * j, sb = q >> 9, within = q & 511, row = within >> 3, ch = (within & 7) ^ ((row >> 1) & 7);
      __builtin_amdgcn_global_load_lds((glb_u32_t*)(kp + (size_t)(key0 + row) * kst + sb * 64 + ch * 8), (lds_u32_t*)(base + q * 16), 16, 0, 0);
    }
#pragma unroll
    for (int j = 0; j < VCH; ++j) {
      const int q = tid + 256 * j, dv = q >> 3, ch = (q & 7) ^ ((dv >> 1) & 7);
      __builtin_amdgcn_global_load_lds((glb_u32_t*)(vp + (size_t)dv * vst + key0 + ch * 8), (lds_u32_t*)(base + VOFF + q * 16), 16, 0, 0);
    }
  };

  f32x16 O[NT];
#pragma unroll
  for (int t = 0; t < NT; ++t)
#pragma unroll
    for (int i = 0; i < 16; ++i) O[t][i] = 0.f;
  float m = has_sink ? sinkv * 8.0f : -1e30f;
  float lsum = (has_sink && hh == 0 && kh == 0) ? 1.0f : 0.f;

  __syncthreads();
  dma(0, 0);
  asm volatile("s_waitcnt vmcnt(0)" ::: "memory");
  __syncthreads();
  for (int it = 0; it < nst; ++it) {
    if (it + 1 < nst) dma(it + 1, (it + 1) & 1);
    __builtin_amdgcn_sched_barrier(0);
    const unsigned char* ksub = lds + (it & 1) * STAGE + koff;
    const unsigned char* vsub = lds + (it & 1) * STAGE + VOFF;
    f32x16 s[NKT];
    {
      bf16x8 kf[NKT][4];
#pragma unroll
      for (int ks = 0; ks < 4; ++ks)
#pragma unroll
        for (int kt = 0; kt < NKT; ++kt) kf[kt][ks] = *(const bf16x8*)(ksub + ((KS ? kh : kt) * 32 + r31) * 128 + (((ks * 2 + hh) ^ swz) << 4));
      __builtin_amdgcn_sched_barrier(0);
      __builtin_amdgcn_s_setprio(1);
#pragma unroll
      for (int kt = 0; kt < NKT; ++kt)
#pragma unroll
        for (int i = 0; i < 16; ++i) s[kt][i] = 0.f;
#pragma unroll
      for (int ks = 0; ks < 4; ++ks)
#pragma unroll
        for (int kt = 0; kt < NKT; ++kt) s[kt] = mfma32(kf[kt][ks], qf[ks], s[kt]);
      __builtin_amdgcn_s_setprio(0);
    }
    bf16x8 vf[2][NT];
#pragma unroll
    for (int t = 0; t < NT; ++t) vf[0][t] = *(const bf16x8*)(vsub + (t * 32 + r31) * 128 + (((kh * 4 + hh) ^ swz) << 4));
    if (MODE == 1 && windowed) {
      int st = it + rot; if (st >= nst) st -= nst;
      if (st >= nt0) {
        const int key0 = (t1lo + st - nt0) * 64, qpos = q0 + r31;
#pragma unroll
        for (int kt = 0; kt < NKT; ++kt)
#pragma unroll
          for (int i = 0; i < 16; ++i) {
            const int kpos = key0 + (KS ? kh : kt) * 32 + (i & 3) + 8 * (i >> 2) + 4 * hh;
            const int d = qpos - kpos;
            if (d > 128 || d < -128) s[kt][i] = -1e30f;
          }
      }
    }
    float mx = s[0][0];
#pragma unroll
    for (int kt = 0; kt < NKT; ++kt)
#pragma unroll
      for (int i = 0; i < 16; ++i) mx = fmaxf(mx, s[kt][i]);
    { const auto sw = __builtin_amdgcn_permlane32_swap(__float_as_uint(mx), __float_as_uint(mx), false, false);
      mx = fmaxf(__uint_as_float(sw[0]), __uint_as_float(sw[1])); }
    if (__any(mx > m + DEFER_RAW)) {
      const float mnew = fmaxf(m, mx);
      const float alpha = __builtin_amdgcn_exp2f((m - mnew) * SC);
      m = mnew;
      lsum *= alpha;
#pragma unroll
      for (int t = 0; t < NT; ++t)
#pragma unroll
        for (int i = 0; i < 16; ++i) O[t][i] *= alpha;
    }
    const float mc = m * SC;
    f32x2 ps2 = {0.f, 0.f};
#pragma unroll
    for (int kt = 0; kt < NKT; ++kt)
#pragma unroll
      for (int i = 0; i < 16; i += 2) {
        const f32x2 sv = {s[kt][i], s[kt][i + 1]};
        const f32x2 tv = sv * SC - mc;
        f32x2 ev; ev.x = __builtin_amdgcn_exp2f(tv.x); ev.y = __builtin_amdgcn_exp2f(tv.y);
        s[kt][i] = ev.x; s[kt][i + 1] = ev.y;
        ps2 += ev;
      }
    lsum += ps2.x + ps2.y;
#pragma unroll
    for (int g = 0; g < NG; ++g) {
      const int kt = KS ? 0 : (g >> 1), sx = g & 1;
      if (g < NG - 1) {
#pragma unroll
        for (int t = 0; t < NT; ++t) vf[(g + 1) & 1][t] = *(const bf16x8*)(vsub + (t * 32 + r31) * 128 + ((((kh * 2 + g + 1) * 2 + hh) ^ swz) << 4));
      }
      __builtin_amdgcn_sched_barrier(0);
      u32x4 pw = {pk2(s[kt][8 * sx + 0], s[kt][8 * sx + 1]), pk2(s[kt][8 * sx + 2], s[kt][8 * sx + 3]),
                  pk2(s[kt][8 * sx + 4], s[kt][8 * sx + 5]), pk2(s[kt][8 * sx + 6], s[kt][8 * sx + 7])};
      const bf16x8 pf = __builtin_bit_cast(bf16x8, pw);
#pragma unroll
      for (int t = 0; t < NT; ++t) O[t] = mfma32(vf[g & 1][t], pf, O[t]);
      __builtin_amdgcn_sched_barrier(0);
    }
    asm volatile("s_waitcnt vmcnt(0)" ::: "memory");
    __syncthreads();
  }
  float* X = (float*)lds;
  if (KS) {
    constexpr int RS = NT * 16 + 2;
    const int pi = w >> 1;
    if (kh == 1) {
#pragma unroll
      for (int t = 0; t < NT; ++t)
#pragma unroll
        for (int i = 0; i < 16; ++i) X[((pi * RS + t * 16 + i) << 6) + lane] = O[t][i];
      X[((pi * RS + NT * 16) << 6) + lane] = m;
      X[((pi * RS + NT * 16 + 1) << 6) + lane] = lsum;
    }
    __syncthreads();
    if (kh == 0) {
      const float m1 = X[((pi * RS + NT * 16) << 6) + lane], l1 = X[((pi * RS + NT * 16 + 1) << 6) + lane];
      const float mm = fmaxf(m, m1);
      const float a0 = __builtin_amdgcn_exp2f((m - mm) * SC), a1 = __builtin_amdgcn_exp2f((m1 - mm) * SC);
#pragma unroll
      for (int t = 0; t < NT; ++t)
#pragma unroll
        for (int i = 0; i < 16; ++i) O[t][i] = O[t][i] * a0 + X[((pi * RS + t * 16 + i) << 6) + lane] * a1;
      lsum = lsum * a0 + l1 * a1;
    }
    __syncthreads();
  }
  const float ltot = lsum + __shfl_xor(lsum, 32);
  const float inv = 1.0f / ltot;
  const int tok = tok0 + qrow;
  if (MODE == 1) {
    if (kh == 0) {
      const bf16_t* zp = qkv + (size_t)tok * 2560 + (isD ? 2048 : 768) + hq * 64;
      bf16_t* op = mix + (size_t)tok * 1024 + (isD ? 512 : 0) + hq * 64;
#pragma unroll
      for (int t = 0; t < NT; ++t)
#pragma unroll
        for (int i4 = 0; i4 < 4; ++i4) {
          const int dv0 = t * 32 + 8 * i4 + 4 * hh;
          const u32x2 z = *(const u32x2*)(zp + dv0);
          u32x2 o = {pk2(O[t][4 * i4] * inv * bf_lo(z[0]), O[t][4 * i4 + 1] * inv * bf_hi(z[0])),
                     pk2(O[t][4 * i4 + 2] * inv * bf_lo(z[1]), O[t][4 * i4 + 3] * inv * bf_hi(z[1]))};
          *(u32x2*)(op + dv0) = o;
        }
    }
  } else {
    const float* lv = p.in[19] + li * 256;
    float d1 = wave_sum(lv[lane] * lv[64 + lane]), d2 = wave_sum(lv[128 + lane] * lv[192 + lane]);
    const float lam_init = (l == 0) ? 0.2f : 0.47071301834358416f;
    const float lam = expf(d1) - expf(d2) + lam_init;
    const int xr = KS ? 0 : (w & 1) * 64;
    if (w >= 2 && kh == 0) {
#pragma unroll
      for (int t = 0; t < NT; ++t)
#pragma unroll
        for (int i = 0; i < 16; ++i) X[((xr + t * 16 + i) << 6) + lane] = O[t][i] * inv;
    }
    __syncthreads();
    if (w < 2 && kh == 0) {
      float ss = 0.f;
#pragma unroll
      for (int t = 0; t < NT; ++t)
#pragma unroll
        for (int i = 0; i < 16; ++i) { const float o = O[t][i] * inv - lam * X[((xr + t * 16 + i) << 6) + lane]; O[t][i] = o; ss += o * o; }
      ss += __shfl_xor(ss, 32);
      const float scale = rsqrtf(ss * (1.0f / 128.0f) + EPS) * (1.0f - lam_init);
      const float* sg = p.in[20] + li * 128;
      const bf16_t* zp = qkv + (size_t)tok * 3072 + 2560 + head * 128;
      bf16_t* op = mix + (size_t)tok * 1024 + 512 + head * 128;
#pragma unroll
      for (int t = 0; t < NT; ++t)
#pragma unroll
        for (int i4 = 0; i4 < 4; ++i4) {
          const int dv0 = t * 32 + 8 * i4 + 4 * hh;
          const u32x2 z = *(const u32x2*)(zp + dv0);
          const f32x4 g = *(const f32x4*)(sg + dv0);
          u32x2 o = {pk2(O[t][4 * i4] * scale * g[0] * bf_lo(z[0]), O[t][4 * i4 + 1] * scale * g[1] * bf_hi(z[0])),
                     pk2(O[t][4 * i4 + 2] * scale * g[2] * bf_lo(z[1]), O[t][4 * i4 + 3] * scale * g[3] * bf_hi(z[1]))};
          *(u32x2*)(op + dv0) = o;
        }
    }
  }
}

DI void conv_task(const Params& p, int l, int tile, unsigned char* lds) {
  const int tid = opaque_tid(), lane = tid & 63, w = tid >> 6;
  const int li = l >> 1;
  const bf16_t* qkv = (const bf16_t*)(p.ws + WS_QKV);
  bf16_t* mix = (bf16_t*)(p.ws + WS_MIX);
  const int t0 = tile * 32;
  const int seq_lo = t0 < NP ? (t0 & ~255) : NP + ((t0 - NP) & ~1023);
  const int seq_hi = seq_lo + (t0 < NP ? 256 : 1024);
  __syncthreads();
  {
    u32x4 v[16];
#pragma unroll
    for (int i = 0; i < 16; ++i) {
      const int c = tid + 256 * i, rr = c >> 6, ch = c & 63, tk = t0 - 15 + rr;
      v[i] = (u32x4){0u, 0u, 0u, 0u};
      if (c < 62 * 64 && tk >= seq_lo && tk < seq_hi) v[i] = *(const u32x4*)(qkv + (size_t)tk * 3072 + ch * 8);
    }
#pragma unroll
    for (int i = 0; i < 16; ++i) {
      const int c = tid + 256 * i, rr = c >> 6, ch = c & 63;
      if (c < 62 * 64) *(u32x4*)(lds + rr * 1024 + ch * 16) = v[i];
    }
  }
  __syncthreads();
  const float* cw = p.in[15] + (size_t)li * 31 * 512;
  const float* cb = p.in[16] + li * 512;
  const float* lg = p.in[17] + li * 512;
  const float* lb = p.in[18] + li * 512;
  float sum[8], sq[8];
#pragma unroll
  for (int tt = 0; tt < 8; ++tt) { sum[tt] = 0.f; sq[tt] = 0.f; }
#pragma unroll 1
  for (int pz = 0; pz < 4; ++pz) {
    const int ch = pz * 128 + lane * 2;
    f32x2 wv[31];
#pragma unroll
    for (int j = 0; j < 31; ++j) wv[j] = *(const f32x2*)(cw + j * 512 + ch);
    const f32x2 bias = *(const f32x2*)(cb + ch);
    float r[8][2];
#pragma unroll
    for (int tt = 0; tt < 8; ++tt) { r[tt][0] = bias[0]; r[tt][1] = bias[1]; }
#pragma unroll
    for (int rr = 0; rr < 38; ++rr) {
      const unsigned xv = *(const unsigned*)(lds + (w * 8 + rr) * 1024 + ch * 2);
      const float x0 = bf_lo(xv), x1 = bf_hi(xv);
#pragma unroll
      for (int tt = 0; tt < 8; ++tt) {
        const int j = rr - tt;
        if (j >= 0 && j < 31) { r[tt][0] += wv[j][0] * x0; r[tt][1] += wv[j][1] * x1; }
      }
    }
#pragma unroll
    for (int tt = 0; tt < 8; ++tt) {
      sum[tt] += r[tt][0] + r[tt][1]; sq[tt] += r[tt][0] * r[tt][0] + r[tt][1] * r[tt][1];
      *(unsigned*)(mix + (size_t)(t0 + w * 8 + tt) * 1024 + ch) = pk2(r[tt][0], r[tt][1]);
    }
  }
#pragma unroll
  for (int tt = 0; tt < 8; ++tt) {
    const float mu = wave_sum(sum[tt]) * (1.0f / 512.0f);
    const float var = wave_sum(sq[tt]) * (1.0f / 512.0f) - mu * mu;
    sum[tt] = mu; sq[tt] = rsqrtf(fmaxf(var, 0.f) + EPS);
  }
#pragma unroll 1
  for (int pz = 0; pz < 4; ++pz) {
    const int ch = pz * 128 + lane * 2;
    const f32x2 g = *(const f32x2*)(lg + ch), bb = *(const f32x2*)(lb + ch);
    unsigned rv[8], zv[8];
#pragma unroll
    for (int tt = 0; tt < 8; ++tt) {
      const int tok = t0 + w * 8 + tt;
      rv[tt] = *(const unsigned*)(mix + (size_t)tok * 1024 + ch);
      zv[tt] = *(const unsigned*)(qkv + (size_t)tok * 3072 + 512 + ch);
    }
#pragma unroll
    for (int tt = 0; tt < 8; ++tt) {
      const int tok = t0 + w * 8 + tt;
      float y0 = (bf_lo(rv[tt]) - sum[tt]) * sq[tt] * g[0] + bb[0], y1 = (bf_hi(rv[tt]) - sum[tt]) * sq[tt] * g[1] + bb[1];
      y0 = y0 * sigmoidf_(y0) * bf_lo(zv[tt]); y1 = y1 * sigmoidf_(y1) * bf_hi(zv[tt]);
      *(unsigned*)(mix + (size_t)tok * 1024 + ch) = pk2(y0, y1);
    }
  }
}

DI void phase_mix(const Params& p, int l, unsigned char* lds) {
  const bool odd = l & 1;
  const int ntask = odd ? 768 : 704;
  const int G = gridDim.x, bid = blockIdx.x;
  for (int r = 0;; ++r) {
    if (r * G >= ntask) break;
    const int t = r * G + ((r & 1) ? (G - 1 - bid) : bid);
    if (t >= ntask) continue;
    if (!odd) {
      if (t < 256) { const int x = t & 7, j = t >> 3; attn_task<0, 1>(p, l, 0, x >> 2, x & 3, j, 0, j, 32, lds); }
      else if (t < 448) conv_task(p, l, t - 256, lds);
      else { const int u = t - 448, x = u & 7, j = u >> 3, sm = (j >> 2) * 8 + x; attn_task<0, 0>(p, l, 1, sm >> 2, sm & 3, j & 3, 0, j & 3, 4, lds); }
    } else {
      if (t < 256) { const int u = t & 127, x = u & 7, j = u >> 3, sm = x & 3; attn_task<1, 0>(p, l, t >> 7, sm >> 1, sm & 1, (x >> 2) * 16 + j, 0, j, 16, lds); }
      else { const int u = (t - 256) & 255, x = u & 7, j = u >> 3, sm = (j >> 3) * 8 + x; attn_task<1, 0>(p, l, 2 + ((t - 256) >> 8), sm >> 1, sm & 1, j & 7, 0, j & 7, 8, lds); }
    }
  }
}

constexpr int LDS_BYTES = 65536 + 64;
__global__ void __launch_bounds__(256, 2) mega(Params p, int ph_lo, int ph_hi) {
  extern __shared__ __attribute__((aligned(16))) unsigned char lds[];
  cg::grid_group grid = cg::this_grid();
  if (ph_lo > 1000) grid.sync();
  volatile LAS unsigned* st = (volatile LAS unsigned*)(lds + 65536);
  if (threadIdx.x == 0) { st[0] = 0u; st[1] = 0u; }
  __syncthreads();
  const XcdBarrier xb = xcd_barrier_post((unsigned*)(p.ws + WS_BAR), st);
  for (int ph = ph_lo; ph < ph_hi; ++ph) {
    if (ph == 0) phase_prep(p, lds);
    else if (ph == 1) phase_post(p, -1, 0);
    else {
      const int l = (ph - 2) >> 2, sub = (ph - 2) & 3;
      if (sub == 0) { const int nt = (l & 1) ? 48 * 20 : 48 * 28; for (int t = blockIdx.x; t < nt; t += gridDim.x) gemm_in_tile(p, l, t, lds); }
      else if (sub == 1) phase_mix(p, l, lds);
      else if (sub == 2) { for (int t = blockIdx.x; t < 384; t += gridDim.x) gemm_out_tile(p, l, t, lds); }
      else phase_post(p, l, l + 1);
    }
    if (ph + 1 < ph_hi) xcd_barrier(xb);
  }
}

#ifndef PER_PHASE_LAUNCH
#define PER_PHASE_LAUNCH 0
#endif

extern "C" void kernel_launch(void* const* d_in, const int* in_sizes, int n_in, void* d_out, int out_size, void* d_ws, size_t ws_size, hipStream_t stream) {
  static int grid_blocks = 0;
  if (!grid_blocks) {
    int dev = 0, cus = 0, per_cu = 0;
    (void)hipGetDevice(&dev);
    (void)hipDeviceGetAttribute(&cus, hipDeviceAttributeMultiprocessorCount, dev);
    (void)hipFuncSetAttribute((const void*)mega, hipFuncAttributeMaxDynamicSharedMemorySize, LDS_BYTES);
    (void)hipOccupancyMaxActiveBlocksPerMultiprocessor(&per_cu, mega, 256, LDS_BYTES);
    if (per_cu < 1) per_cu = 1;
    if (per_cu > 2) per_cu = 2;
    grid_blocks = cus * per_cu;
    if (n_in != 27 || ws_size < WS_END) fprintf(stderr, "kernel_launch: unexpected n_in %d / ws %zu\n", n_in, ws_size);
  }
  (void)hipMemsetAsync(d_ws, 0, 16384, stream);
  Params p{};
  for (int i = 0; i < 27; ++i) p.in[i] = (const float*)d_in[i];
  p.out = (float*)d_out; p.ws = (unsigned char*)d_ws;
#if PER_PHASE_LAUNCH
  for (int ph = 0; ph < NPHASE; ++ph) hipLaunchKernelGGL(mega, dim3(grid_blocks), dim3(256), LDS_BYTES, stream, p, ph, ph + 1);
#else
  int lo = 0, hi = NPHASE;
  void* args[] = {&p, &lo, &hi};
  hipError_t e = hipLaunchCooperativeKernel((void*)mega, dim3(grid_blocks), dim3(256), args, LDS_BYTES, stream);
  if (e != hipSuccess) fprintf(stderr, "cooperative launch failed: %s (grid %d)\n", hipGetErrorString(e), grid_blocks);
#endif
}
```

```cpp
#include <hip/hip_runtime.h>
#include <hip/hip_cooperative_groups.h>
#include <cstdio>
#include <cstdint>
namespace cg = cooperative_groups;

#define DI __device__ __forceinline__
typedef unsigned short bf16_t;
typedef short bf16x8 __attribute__((ext_vector_type(8)));
typedef short s16x4 __attribute__((ext_vector_type(4)));
typedef float f32x16 __attribute__((ext_vector_type(16)));
typedef float f32x4 __attribute__((ext_vector_type(4)));
typedef float f32x2 __attribute__((ext_vector_type(2)));
typedef unsigned u32x4 __attribute__((ext_vector_type(4)));
typedef unsigned u32x2 __attribute__((ext_vector_type(2)));
typedef __bf16 bf2_t __attribute__((ext_vector_type(2)));

DI unsigned pk2(float lo, float hi) { f32x2 v = {lo, hi}; return __builtin_bit_cast(unsigned, __builtin_convertvector(v, bf2_t)); }
DI float bf_lo(unsigned u) { return __uint_as_float(u << 16); }
DI float bf_hi(unsigned u) { return __uint_as_float(u & 0xffff0000u); }
DI f32x16 mfma32(bf16x8 a, bf16x8 b, f32x16 c) { return __builtin_amdgcn_mfma_f32_32x32x16_bf16(a, b, c, 0, 0, 0); }
DI float sigmoidf_(float x) { return __builtin_amdgcn_rcpf(1.0f + __expf(-x)); }
DI int opaque_tid() { int t = threadIdx.x; asm volatile("" : "+v"(t)); return t; }
template <int CTRL> DI float dpp_f(float v) { return __builtin_bit_cast(float, __builtin_amdgcn_update_dpp(0, __builtin_bit_cast(int, v), CTRL, 0xF, 0xF, true)); }
DI float wave_sum(float v) {
  v += dpp_f<0xB1>(v);
  v += dpp_f<0x4E>(v);
  v += dpp_f<0x141>(v);
  v += dpp_f<0x140>(v);
  v += __shfl_xor(v, 16);
  const auto sw = __builtin_amdgcn_permlane32_swap(__float_as_uint(v), __float_as_uint(v), false, false);
  return __uint_as_float(sw[0]) + __uint_as_float(sw[1]);
}

constexpr int NTOK = 6144, NP = 4096;
constexpr float EPS = 1e-6f;
constexpr size_t OFF_NBK = 6291456, OFF_NBV = 10485760, OFF_NCK = 14680064, OFF_NCV = 15728640, OFF_NDK = 16777216, OFF_NDV = 17825792;
constexpr size_t WS_CTR = 0;
constexpr size_t WS_BAR = 1024;
constexpr size_t WS_MOD = 16384;
constexpr size_t WS_WIE = WS_MOD + 147456;
constexpr size_t WS_WOE = WS_WIE + 14680064;
constexpr size_t WS_WIO = WS_WOE + 4194304;
constexpr size_t WS_WOO = WS_WIO + 10485760;
constexpr size_t WS_CBK = WS_WOO + 4194304;
constexpr size_t WS_CBV = WS_CBK + 2097152;
constexpr size_t WS_CCK = WS_CBV + 2097152;
constexpr size_t WS_CCV = WS_CCK + 524288;
constexpr size_t WS_CDK = WS_CCV + 524288;
constexpr size_t WS_CDV = WS_CDK + 524288;
constexpr size_t WS_H = WS_CDV + 524288;
constexpr size_t WS_QKV = WS_H + 12582912;
constexpr size_t WS_VT = WS_QKV + 37748736;
constexpr size_t WS_VTD = WS_VT + 1572864;
constexpr size_t WS_MIX = WS_VT + 6291456;
constexpr size_t WS_O = WS_MIX + 12582912;
constexpr size_t WS_END = WS_O + 25165824;

struct Params {
  const float* in[27];
  float* out;
  unsigned char* ws;
};

constexpr int NPHASE = 18;


#define XB_TMO      128
#define XB_XCNT(j)  (256  + 64 * (j))
#define XB_XSUB(j)  (1280 + 64 * (j))
#define XB_XGEN(j)  (2304 + 64 * (j))
#define XB_TOP      3328
#define XB_TOPGEN   3392
#define XCD_BAR_WORDS 3456
#define XB_SPIN_CAP (1u << 18)
#define LAS __attribute__((address_space(3)))
DI unsigned xb_ld(unsigned* p) { return __hip_atomic_load(p, __ATOMIC_RELAXED, __HIP_MEMORY_SCOPE_AGENT); }
DI unsigned xb_add(unsigned* p, unsigned v) { return __hip_atomic_fetch_add(p, v, __ATOMIC_RELAXED, __HIP_MEMORY_SCOPE_AGENT); }
DI unsigned xb_xcc_id() { return (unsigned)__builtin_amdgcn_s_getreg((3 << 11) | 20) & 0xFu; }
#define XB_SPIN(cond, bar) do { unsigned _sp = 0; while (cond) { __builtin_amdgcn_s_sleep(1); \
    if ((++_sp & 255u) == 0u) { if (xb_ld(&(bar)[XB_TMO])) break; if (_sp > XB_SPIN_CAP) { atomicAdd(&(bar)[XB_TMO], 1u); break; } } } } while (0)
struct XcdBarrier { unsigned* bar; unsigned x; volatile LAS unsigned* st; };
DI XcdBarrier xcd_barrier_post(unsigned* bar, volatile LAS unsigned* st) {
  XcdBarrier b; b.bar = bar; b.x = xb_xcc_id(); b.st = st;
  if (threadIdx.x == 0) (void)xb_add(&bar[XB_XCNT(b.x)], 1u);
  return b;
}
DI void xcd_barrier_complete(unsigned* bar, unsigned x, unsigned& nloc, unsigned& nx) {
  const unsigned G = gridDim.x * gridDim.y * gridDim.z;
  unsigned sum, cnt, mine, sp = 0u;
  for (;;) {
    sum = 0u; cnt = 0u; mine = 0u;
#pragma unroll
    for (unsigned j = 0; j < 16; ++j) { const unsigned c = xb_ld(&bar[XB_XCNT(j)]); sum += c; cnt += (c > 0u) ? 1u : 0u; mine = (j == x) ? c : mine; }
    if (sum == G) break;
    __builtin_amdgcn_s_sleep(1);
    if ((++sp & 255u) == 0u) { if (xb_ld(&bar[XB_TMO])) break; if (sp > XB_SPIN_CAP) { atomicAdd(&bar[XB_TMO], 1u); break; } }
  }
  nloc = mine > 0u ? mine : 1u; nx = cnt > 0u ? cnt : 1u;
}
DI void xcd_barrier(const XcdBarrier& b) {
  asm volatile("s_waitcnt vmcnt(0)" ::: "memory");
  __syncthreads();
  if (threadIdx.x == 0) {
    unsigned* bar = b.bar;
    __builtin_amdgcn_s_waitcnt(0);
    unsigned nloc = b.st[0], nx = b.st[1];
    if (nloc == 0u) { xcd_barrier_complete(bar, b.x, nloc, nx); b.st[0] = nloc; b.st[1] = nx; }
    const unsigned old = xb_add(&bar[XB_XSUB(b.x)], 1u);
    const unsigned gen = old / nloc;
    if (old + 1u == (gen + 1u) * nloc) {
      __builtin_amdgcn_fence(__ATOMIC_RELEASE, "agent");
      asm volatile("s_waitcnt vmcnt(0)" ::: "memory");
      const unsigned og = xb_add(&bar[XB_TOP], 1u);
      const unsigned tg = og / nx;
      if (og + 1u == (tg + 1u) * nx) xb_add(&bar[XB_TOPGEN], 1u);
      else XB_SPIN(xb_ld(&bar[XB_TOPGEN]) == tg, bar);
      __builtin_amdgcn_fence(__ATOMIC_ACQUIRE, "agent");
      xb_add(&bar[XB_XGEN(b.x)], 1u);
      asm volatile("s_waitcnt vmcnt(0)" ::: "memory");
    } else {
      XB_SPIN(xb_ld(&bar[XB_XGEN(b.x)]) == gen, bar);
      __builtin_amdgcn_fence(__ATOMIC_ACQUIRE, "agent");
      asm volatile("s_waitcnt vmcnt(0)" ::: "memory");
    }
  }
  __syncthreads();
}

template <bool PERMK>
DI void trans_tile(const float* __restrict__ src, int sstride, bf16_t* __restrict__ dst, int dstride, unsigned char* lds) {
  bf16_t* T = (bf16_t*)lds;
  const int tid = opaque_tid();
  __syncthreads();
#pragma unroll
  for (int ps = 0; ps < 4; ++ps) {
    const int ksrc = (tid >> 4) + 16 * ps, nn = (tid & 15) * 4;
    const int kk = PERMK ? ((ksrc & ~12) | ((ksrc & 4) << 1) | ((ksrc & 8) >> 1)) : ksrc;
    const f32x4 v = __builtin_nontemporal_load((const f32x4*)(src + (size_t)ksrc * sstride + nn));
    const unsigned a = pk2(v[0], v[1]), b = pk2(v[2], v[3]);
    T[(nn + 0) * 66 + kk] = (bf16_t)(a & 0xffffu);
    T[(nn + 1) * 66 + kk] = (bf16_t)(a >> 16);
    T[(nn + 2) * 66 + kk] = (bf16_t)(b & 0xffffu);
    T[(nn + 3) * 66 + kk] = (bf16_t)(b >> 16);
  }
  __syncthreads();
  const int n = tid >> 2, ch = tid & 3;
  const unsigned* Tr = (const unsigned*)(T + n * 66 + ch * 16);
  u32x4 o0 = {Tr[0], Tr[1], Tr[2], Tr[3]}, o1 = {Tr[4], Tr[5], Tr[6], Tr[7]};
  u32x4* d = (u32x4*)(dst + (size_t)n * dstride + ch * 16);
  d[0] = o0; d[1] = o1;
}

DI void conv_tile4096(const float* __restrict__ src, bf16_t* __restrict__ dst) {
  const int tid = opaque_tid();
#pragma unroll
  for (int ps = 0; ps < 4; ++ps) {
    const int e = ps * 1024 + tid * 4;
    const f32x4 v = __builtin_nontemporal_load((const f32x4*)(src + e));
    u32x2 o = {pk2(v[0], v[1]), pk2(v[2], v[3])};
    *(u32x2*)(dst + e) = o;
  }
}

DI void mod_tile(const Params& p, int t, unsigned char* lds) {
  const int l = t / 96, grp = t % 96;
  float* sc = (float*)lds;
  float* red = (float*)(lds + 12288);
  const int tid = opaque_tid();
  __syncthreads();
  for (int idx = tid; idx < 3072; idx += 256) {
    const int r = idx >> 10, k = idx & 1023;
    const float c = (r == 0) ? p.in[9][k] : p.in[8][(r - 1) * 1024 + k];
    sc[idx] = c / (1.0f + expf(-c));
  }
  __syncthreads();
  const int cg4 = tid & 7, kr = tid >> 3;
  const float* W = p.in[12] + (size_t)l * 1024 * 3072 + grp * 32 + cg4 * 4;
  f32x4 a0 = {0, 0, 0, 0}, a1 = {0, 0, 0, 0}, a2 = {0, 0, 0, 0};
#pragma unroll 8
  for (int ps = 0; ps < 32; ++ps) {
    const int k = kr + 32 * ps;
    const f32x4 wv = __builtin_nontemporal_load((const f32x4*)(W + (size_t)k * 3072));
    a0 += sc[k] * wv; a1 += sc[1024 + k] * wv; a2 += sc[2048 + k] * wv;
  }
  float* rp = red + (kr * 8 + cg4) * 12;
  *(f32x4*)(rp) = a0; *(f32x4*)(rp + 4) = a1; *(f32x4*)(rp + 8) = a2;
  __syncthreads();
  if (tid < 96) {
    const int r = tid >> 5, c = tid & 31;
    float s = 0.f;
    for (int k2 = 0; k2 < 32; ++k2) s += red[(k2 * 8 + (c >> 2)) * 12 + r * 4 + (c & 3)];
    float* mod = (float*)(p.ws + WS_MOD);
    mod[(l * 3 + r) * 3072 + grp * 32 + c] = s + p.in[13][l * 3072 + grp * 32 + c];
  }
}

DI void wdesc(const Params& p, int u, const float*& src, int& ss, bf16_t*& dst) {
  if (u < 1792) {
    const int i = u / 896, v = u % 896, kt = v & 15, dt = v >> 4;
    const int sb = dt < 16 ? ((dt & 1) ? 8 + (dt >> 1) : (dt >> 1)) : dt;
    src = p.in[14] + (size_t)i * 1024 * 3584 + (size_t)kt * 64 * 3584 + sb * 64; ss = 3584;
    dst = (bf16_t*)(p.ws + WS_WIE) + (size_t)i * 3584 * 1024 + (size_t)dt * 64 * 1024 + kt * 64;
  } else if (u < 2304) {
    u -= 1792; const int i = u >> 8, v = u & 255, kt = v & 15, dt = v >> 4;
    src = p.in[21] + (size_t)i * 1024 * 1024 + (size_t)kt * 64 * 1024 + dt * 64; ss = 1024;
    dst = (bf16_t*)(p.ws + WS_WOE) + (size_t)i * 1024 * 1024 + (size_t)dt * 64 * 1024 + kt * 64;
  } else if (u < 3584) {
    u -= 2304; const int i = u / 640, v = u % 640, kt = v & 15, dt = v >> 4;
    src = p.in[22] + (size_t)i * 1024 * 2560 + (size_t)kt * 64 * 2560 + dt * 64; ss = 2560;
    dst = (bf16_t*)(p.ws + WS_WIO) + (size_t)i * 2560 * 1024 + (size_t)dt * 64 * 1024 + kt * 64;
  } else {
    u -= 3584; const int i = u >> 8, v = u & 255, kt = v & 15, dt = v >> 4;
    src = p.in[26] + (size_t)i * 1024 * 1024 + (size_t)kt * 64 * 1024 + dt * 64; ss = 1024;
    dst = (bf16_t*)(p.ws + WS_WOO) + (size_t)i * 1024 * 1024 + (size_t)dt * 64 * 1024 + kt * 64;
  }
}
DI void phase_prep(const Params& p, unsigned char* lds) {
  const int tid = opaque_tid();
  for (int t = blockIdx.x; t < 384; t += gridDim.x) mod_tile(p, t, lds);
  {
    bf16_t* T = (bf16_t*)lds;
    f32x4 cur[4], nxt[4];
    const float* src; int ss; bf16_t* dst;
    int u = blockIdx.x;
    if (u < 4096) {
      wdesc(p, u, src, ss, dst);
#pragma unroll
      for (int ps = 0; ps < 4; ++ps) cur[ps] = __builtin_nontemporal_load((const f32x4*)(src + (size_t)((tid >> 4) + 16 * ps) * ss + (tid & 15) * 4));
    }
    while (u < 4096) {
      const int un = u + gridDim.x;
      bf16_t* dcur = dst;
      if (un < 4096) {
        wdesc(p, un, src, ss, dst);
#pragma unroll
        for (int ps = 0; ps < 4; ++ps) nxt[ps] = __builtin_nontemporal_load((const f32x4*)(src + (size_t)((tid >> 4) + 16 * ps) * ss + (tid & 15) * 4));
      }
      __builtin_amdgcn_sched_barrier(0);
      __syncthreads();
#pragma unroll
      for (int ps = 0; ps < 4; ++ps) {
        const int kk = (tid >> 4) + 16 * ps, nn = (tid & 15) * 4;
        const unsigned a = pk2(cur[ps][0], cur[ps][1]), b2 = pk2(cur[ps][2], cur[ps][3]);
        T[(nn + 0) * 66 + kk] = (bf16_t)(a & 0xffffu);
        T[(nn + 1) * 66 + kk] = (bf16_t)(a >> 16);
        T[(nn + 2) * 66 + kk] = (bf16_t)(b2 & 0xffffu);
        T[(nn + 3) * 66 + kk] = (bf16_t)(b2 >> 16);
      }
      __syncthreads();
      {
        const int n = tid >> 2, ch = tid & 3;
        const unsigned* Tr = (const unsigned*)(T + n * 66 + ch * 16);
        u32x4 o0 = {Tr[0], Tr[1], Tr[2], Tr[3]}, o1 = {Tr[4], Tr[5], Tr[6], Tr[7]};
        u32x4* d = (u32x4*)(dcur + (size_t)n * 1024 + ch * 16);
        d[0] = o0; d[1] = o1;
      }
#pragma unroll
      for (int ps = 0; ps < 4; ++ps) cur[ps] = nxt[ps];
      u = un;
    }
  }
  for (int t = 4480 + blockIdx.x; t < 5248; t += gridDim.x) {
    if (t < 4864) {
      int u = t - 4480;
      if (u < 256) {
        const int bi = u >> 6, v = u & 63, kt = v & 7, ct = v >> 3;
        trans_tile<true>(p.in[3] + ((size_t)bi * 512 + kt * 64) * 512 + ct * 64, 512,
                   (bf16_t*)(p.ws + WS_CBV) + ((size_t)bi * 512 + ct * 64) * 512 + kt * 64, 512, lds);
      } else {
        const bool isd = u >= 320; u -= isd ? 320 : 256;
        const int bi = u >> 4, v = u & 15, kt = v & 7, ct = v >> 3;
        trans_tile<true>(p.in[isd ? 7 : 5] + ((size_t)bi * 512 + kt * 64) * 128 + ct * 64, 128,
                   (bf16_t*)(p.ws + (isd ? WS_CDV : WS_CCV)) + ((size_t)bi * 128 + ct * 64) * 512 + kt * 64, 512, lds);
      }
    } else {
      int u = t - 4864;
      if (u < 256) conv_tile4096(p.in[2] + (size_t)u * 4096, (bf16_t*)(p.ws + WS_CBK) + (size_t)u * 4096);
      else if (u < 320) conv_tile4096(p.in[4] + (size_t)(u - 256) * 4096, (bf16_t*)(p.ws + WS_CCK) + (size_t)(u - 256) * 4096);
      else conv_tile4096(p.in[6] + (size_t)(u - 320) * 4096, (bf16_t*)(p.ws + WS_CDK) + (size_t)(u - 320) * 4096);
    }
  }
}

DI void phase_post(const Params& p, int ldone, int lnext) {
  const int tid = opaque_tid(); const int lane = tid & 63, w = tid >> 6;
  const float* mod = (const float*)(p.ws + WS_MOD);
  const bf16_t* O = (const bf16_t*)(p.ws + WS_O);
  bf16_t* H = (bf16_t*)(p.ws + WS_H);
  for (int row = blockIdx.x * 4 + w; row < NTOK; row += gridDim.x * 4) {
    const int r = row < NP ? 0 : 1 + ((row - NP) >> 10);
    const float* xin = (ldone <= 0) ? (row < NP ? p.in[0] + (size_t)row * 1024 : p.in[1] + (size_t)(row - NP) * 1024) : p.out + (size_t)row * 1024;
    f32x4 x[4], gv[4], nv[4], shv[4], scv[4], npv[4]; u32x2 ov[4];
#pragma unroll
    for (int j = 0; j < 4; ++j) x[j] = *(const f32x4*)(xin + lane * 4 + 256 * j);
    if (ldone >= 0) {
      const float* g = mod + (size_t)(ldone * 3 + r) * 3072 + 2048;
      const float* np_ = p.in[11] + ldone * 1024;
#pragma unroll
      for (int j = 0; j < 4; ++j) { ov[j] = *(const u32x2*)(O + (size_t)row * 1024 + lane * 4 + 256 * j); gv[j] = *(const f32x4*)(g + lane * 4 + 256 * j); nv[j] = *(const f32x4*)(np_ + lane * 4 + 256 * j); }
    }
    if (lnext < 4) {
      const float* sh = mod + (size_t)(lnext * 3 + r) * 3072;
      const float* npre = p.in[10] + lnext * 1024;
#pragma unroll
      for (int j = 0; j < 4; ++j) { const int c = lane * 4 + 256 * j; shv[j] = *(const f32x4*)(sh + c); scv[j] = *(const f32x4*)(sh + 1024 + c); npv[j] = *(const f32x4*)(npre + c); }
    }
    __builtin_amdgcn_sched_barrier(0);
    if (ldone >= 0) {
      f32x4 o[4]; float ss = 0.f;
#pragma unroll
      for (int j = 0; j < 4; ++j) { o[j] = (f32x4){bf_lo(ov[j][0]), bf_hi(ov[j][0]), bf_lo(ov[j][1]), bf_hi(ov[j][1])}; ss += o[j][0] * o[j][0] + o[j][1] * o[j][1] + o[j][2] * o[j][2] + o[j][3] * o[j][3]; }
      ss = wave_sum(ss);
      const float rs = rsqrtf(ss * (1.0f / 1024.0f) + EPS);
#pragma unroll
      for (int j = 0; j < 4; ++j) {
        x[j] = x[j] + gv[j] * (o[j] * rs * nv[j]);
        *(f32x4*)(p.out + (size_t)row * 1024 + lane * 4 + 256 * j) = x[j];
      }
    }
    if (lnext < 4) {
      float ss = 0.f;
#pragma unroll
      for (int j = 0; j < 4; ++j) ss += x[j][0] * x[j][0] + x[j][1] * x[j][1] + x[j][2] * x[j][2] + x[j][3] * x[j][3];
      ss = wave_sum(ss);
      const float rs = rsqrtf(ss * (1.0f / 1024.0f) + EPS);
#pragma unroll
      for (int j = 0; j < 4; ++j) {
        const int c = lane * 4 + 256 * j;
        const f32x4 hv = x[j] * rs * npv[j] * (1.0f + scv[j]) + shv[j];
        u32x2 o2 = {pk2(hv[0], hv[1]), pk2(hv[2], hv[3])};
        *(u32x2*)(H + (size_t)row * 1024 + c) = o2;
      }
    }
  }
}

DI void gemm_core(const bf16_t* __restrict__ A, const bf16_t* __restrict__ B, int K, f32x16 (&acc)[2][2], unsigned char* lds) {
  const int tid = opaque_tid(), lane = tid & 63, w = tid >> 6, wr = w >> 1, wc = w & 1, r31 = lane & 31, hh = lane >> 5;
  u32x4 ra[4], rb[4];
#pragma unroll
  for (int mi = 0; mi < 2; ++mi)
#pragma unroll
    for (int ni = 0; ni < 2; ++ni)
#pragma unroll
      for (int i = 0; i < 16; ++i) acc[mi][ni][i] = 0.f;
  __syncthreads();
#pragma unroll
  for (int i = 0; i < 4; ++i) {
    const int c = tid + 256 * i, row = c >> 3, ch = c & 7;
    ra[i] = *(const u32x4*)(A + (size_t)row * K + ch * 8);
    rb[i] = *(const u32x4*)(B + (size_t)row * K + ch * 8);
  }
#pragma unroll
  for (int i = 0; i < 4; ++i) {
    const int c = tid + 256 * i, row = c >> 3, ch = c & 7, off = row * 128 + ((ch ^ ((row >> 1) & 7)) << 4);
    *(u32x4*)(lds + off) = ra[i]; *(u32x4*)(lds + 16384 + off) = rb[i];
  }
  __syncthreads();
  const int nk = K >> 6;
  for (int kt = 0; kt < nk; ++kt) {
    if (kt + 1 < nk) {
#pragma unroll
      for (int i = 0; i < 4; ++i) {
        const int c = tid + 256 * i, row = c >> 3, ch = c & 7;
        ra[i] = *(const u32x4*)(A + (size_t)row * K + (kt + 1) * 64 + ch * 8);
        rb[i] = *(const u32x4*)(B + (size_t)row * K + (kt + 1) * 64 + ch * 8);
      }
    }
    __builtin_amdgcn_sched_barrier(0);
    const unsigned char* sa = lds + (kt & 1) * 32768 + (wr * 64 + r31) * 128;
    const unsigned char* sb = lds + (kt & 1) * 32768 + 16384 + (wc * 64 + r31) * 128;
    const int sx = (r31 >> 1) & 7;
    bf16x8 af[2][2], bfr[2][2];
#pragma unroll
    for (int mi = 0; mi < 2; ++mi) af[0][mi] = *(const bf16x8*)(sa + mi * 4096 + ((hh ^ sx) << 4));
#pragma unroll
    for (int ni = 0; ni < 2; ++ni) bfr[0][ni] = *(const bf16x8*)(sb + ni * 4096 + ((hh ^ sx) << 4));
#pragma unroll
    for (int ks = 0; ks < 4; ++ks) {
      if (ks < 3) {
        const int sw = (((ks + 1) * 2 + hh) ^ sx) << 4;
#pragma unroll
        for (int mi = 0; mi < 2; ++mi) af[(ks + 1) & 1][mi] = *(const bf16x8*)(sa + mi * 4096 + sw);
#pragma unroll
        for (int ni = 0; ni < 2; ++ni) bfr[(ks + 1) & 1][ni] = *(const bf16x8*)(sb + ni * 4096 + sw);
      }
      __builtin_amdgcn_sched_barrier(0);
#pragma unroll
      for (int mi = 0; mi < 2; ++mi)
#pragma unroll
        for (int ni = 0; ni < 2; ++ni) acc[mi][ni] = mfma32(af[ks & 1][mi], bfr[ks & 1][ni], acc[mi][ni]);
      __builtin_amdgcn_sched_barrier(0);
    }
    if (kt + 1 < nk) {
      unsigned char* da = lds + ((kt + 1) & 1) * 32768;
#pragma unroll
      for (int i = 0; i < 4; ++i) {
        const int c = tid + 256 * i, row = c >> 3, ch = c & 7, off = row * 128 + ((ch ^ ((row >> 1) & 7)) << 4);
        *(u32x4*)(da + off) = ra[i]; *(u32x4*)(da + 16384 + off) = rb[i];
      }
    }
    __syncthreads();
  }
}

__device__ const float INVF[16] = {1.0f, 0.5623413252f, 0.3162277660f, 0.1778279410f, 0.1f, 0.05623413252f, 0.03162277660f, 0.01778279410f,
                                   0.01f, 0.005623413252f, 0.003162277660f, 0.001778279410f, 0.001f, 0.0005623413252f, 0.0003162277660f, 0.0001778279410f};

DI void gemm_in_tile(const Params& p, int l, int tile, unsigned char* lds) {
  const int tid = opaque_tid(), lane = tid & 63, w = tid >> 6, wr = w >> 1, wc = w & 1, r31 = lane & 31, hh = lane >> 5;
  const bool odd = l & 1; const int li = l >> 1;
  const int NTL = odd ? 20 : 28;
  const int mt = tile / NTL, nt = tile % NTL;
  const bool samp = mt >= 32;
  const bf16_t* A = (const bf16_t*)(p.ws + WS_H) + (size_t)mt * 128 * 1024;
  const bf16_t* B = (const bf16_t*)(p.ws + (odd ? WS_WIO : WS_WIE)) + (size_t)li * (odd ? 2560 : 3584) * 1024 + (size_t)nt * 128 * 1024;
  f32x16 acc[2][2];
  gemm_core(A, B, 1024, acc, lds);

  float* stage = (float*)lds;
  bf16_t* qkv = (bf16_t*)(p.ws + WS_QKV);
  int type = 0; bool do_silu = false, do_rope = false; const float* gnorm = nullptr; float* f32out = nullptr; int W = 128; int outcol = 0; int qstride;
  bf16_t* vtbase = nullptr; int ncv = 128, vcol0 = 0;
  if (!odd) {
    qstride = 3072;
    if (nt < 8) { type = 1; outcol = nt * 64; }
    else if (nt < 12) { do_silu = true; outcol = 512 + (nt - 8) * 128; }
    else if (nt < 16) { do_rope = samp; outcol = 1024 + (nt - 12) * 128; }
    else if (nt < 20) { do_rope = samp; outcol = 1536 + (nt - 16) * 128; W = 512; f32out = p.out + OFF_NBK + (size_t)li * 256 * 512 + (nt - 16) * 128; }
    else if (nt < 24) { type = 2; vtbase = (bf16_t*)(p.ws + WS_VT); ncv = 512; vcol0 = (nt - 20) * 128; W = 512; f32out = p.out + OFF_NBV + (size_t)li * 256 * 512 + (nt - 20) * 128; }
    else { do_silu = true; outcol = 2560 + (nt - 24) * 128; }
  } else {
    qstride = 2560; outcol = nt * 128;
    if (nt < 4) { gnorm = p.in[23] + li * 64; do_rope = samp; }
    else if (nt == 4) { gnorm = p.in[24] + li * 64; do_rope = samp; f32out = p.out + OFF_NCK + (size_t)li * 256 * 128; }
    else if (nt == 5) { type = 2; vtbase = (bf16_t*)(p.ws + WS_VT); f32out = p.out + OFF_NCV + (size_t)li * 256 * 128; }
    else if (nt < 10) { do_silu = true; }
    else if (nt < 14) { do_rope = samp; }
    else if (nt == 14) { do_rope = samp; f32out = p.out + OFF_NDK + (size_t)li * 256 * 128; }
    else if (nt == 15) { type = 2; vtbase = (bf16_t*)(p.ws + WS_VTD); f32out = p.out + OFF_NDV + (size_t)li * 256 * 128; }
    else { do_silu = true; }
  }
  if (samp) f32out = nullptr;

#pragma unroll 1
  for (int half = 0; half < 2; ++half) {
    __syncthreads();
    if (wr == half) {
#pragma unroll
      for (int mi = 0; mi < 2; ++mi)
#pragma unroll
        for (int ni = 0; ni < 2; ++ni)
#pragma unroll
          for (int i = 0; i < 16; ++i)
            stage[(mi * 32 + (i & 3) + 8 * (i >> 2) + 4 * hh) * 132 + wc * 64 + ni * 32 + r31] = acc[mi][ni][i];
    }
    __syncthreads();
    const int tokbase = mt * 128 + half * 64;
    const int row = tid >> 2, cc = tid & 3, tok = tokbase + row;
    if (type == 1) {
      float u[16], g[16];
#pragma unroll
      for (int j = 0; j < 4; ++j) {
        const f32x4 a = *(const f32x4*)(stage + row * 132 + cc * 16 + j * 4), b = *(const f32x4*)(stage + row * 132 + 64 + cc * 16 + j * 4);
#pragma unroll
        for (int e = 0; e < 4; ++e) { u[j * 4 + e] = a[e]; g[j * 4 + e] = b[e]; }
      }
      unsigned o[8];
#pragma unroll
      for (int j = 0; j < 8; ++j) o[j] = pk2(u[2 * j] * sigmoidf_(g[2 * j]), u[2 * j + 1] * sigmoidf_(g[2 * j + 1]));
      u32x4* d = (u32x4*)(qkv + (size_t)tok * 3072 + outcol + cc * 16);
      d[0] = (u32x4){o[0], o[1], o[2], o[3]}; d[1] = (u32x4){o[4], o[5], o[6], o[7]};
    } else {
      if (type == 0 || f32out) {
        float v[32];
#pragma unroll
        for (int j = 0; j < 8; ++j) {
          const f32x4 a = *(const f32x4*)(stage + row * 132 + cc * 32 + j * 4);
#pragma unroll
          for (int e = 0; e < 4; ++e) v[j * 4 + e] = a[e];
        }
        if (gnorm) {
          float ss = 0.f;
#pragma unroll
          for (int j = 0; j < 32; ++j) ss += v[j] * v[j];
          ss += __shfl_xor(ss, 1);
          const float rs = rsqrtf(ss * (1.0f / 64.0f) + EPS);
          const float* g = gnorm + (cc & 1) * 32;
#pragma unroll
          for (int j = 0; j < 32; ++j) v[j] *= rs * g[j];
        }
        if (f32out) {
          const int b = tok >> 8, s = tok & 255;
          float* o = f32out + ((size_t)b * 512 + s) * W + cc * 32;
#pragma unroll
          for (int j = 0; j < 8; ++j) *(f32x4*)(o + j * 4) = (f32x4){v[j * 4], v[j * 4 + 1], v[j * 4 + 2], v[j * 4 + 3]};
        }
        if (type == 0) {
          if (do_rope) {
            const int s = (tok - NP) & 1023;
            const float pos = (float)((cc & 1) ? (s & 63) : (s >> 6));
#pragma unroll
            for (int f = 0; f < 16; ++f) {
              const float ang = pos * INVF[f];
              const float sn = __sinf(ang), cs = __cosf(ang);
              const float x1 = v[f], x2 = v[16 + f];
              v[f] = x1 * cs - x2 * sn; v[16 + f] = x2 * cs + x1 * sn;
            }
          }
          if (do_silu) {
#pragma unroll
            for (int j = 0; j < 32; ++j) v[j] = v[j] * sigmoidf_(v[j]);
          }
          u32x4* d = (u32x4*)(qkv + (size_t)tok * qstride + outcol + cc * 32);
#pragma unroll
          for (int j = 0; j < 4; ++j) d[j] = (u32x4){pk2(v[j * 8], v[j * 8 + 1]), pk2(v[j * 8 + 2], v[j * 8 + 3]), pk2(v[j * 8 + 4], v[j * 8 + 5]), pk2(v[j * 8 + 6], v[j * 8 + 7])};
        }
      }
      if (type == 2) {
        const int c = tid & 127, rg = tid >> 7;
        unsigned o[16];
#pragma unroll
        for (int j = 0; j < 16; ++j) o[j] = pk2(stage[(rg * 32 + 2 * j) * 132 + c], stage[(rg * 32 + 2 * j + 1) * 132 + c]);
        const int t0 = tokbase + rg * 32;
        size_t idx;
        if (!samp) { const int b = t0 >> 8, s0 = t0 & 255; idx = ((size_t)b * ncv + vcol0 + c) * 256 + s0; }
        else { const int ts = t0 - NP, b = ts >> 10, s0 = ts & 1023; idx = (size_t)NP * ncv + ((size_t)b * ncv + vcol0 + c) * 1024 + s0; }
        u32x4* d = (u32x4*)(vtbase + idx);
#pragma unroll
        for (int j = 0; j < 4; ++j) {
          const int q0 = 4 * j;
          d[j] = (u32x4){o[(q0 & ~6) | ((q0 & 2) << 1) | ((q0 & 4) >> 1)], o[((q0 + 1) & ~6) | (((q0 + 1) & 2) << 1) | (((q0 + 1) & 4) >> 1)],
                         o[((q0 + 2) & ~6) | (((q0 + 2) & 2) << 1) | (((q0 + 2) & 4) >> 1)], o[((q0 + 3) & ~6) | (((q0 + 3) & 2) << 1) | (((q0 + 3) & 4) >> 1)]};
        }
      }
    }
  }
}

DI void gemm_out_tile(const Params& p, int l, int tile, unsigned char* lds) {
  const int tid = opaque_tid(), lane = tid & 63, w = tid >> 6, wr = w >> 1, wc = w & 1, r31 = lane & 31, hh = lane >> 5;
  const bool odd = l & 1; const int li = l >> 1;
  const int mt = tile >> 3, nt = tile & 7;
  const bf16_t* A = (const bf16_t*)(p.ws + WS_MIX) + (size_t)mt * 128 * 1024;
  const bf16_t* B = (const bf16_t*)(p.ws + (odd ? WS_WOO : WS_WOE)) + (size_t)li * 1024 * 1024 + (size_t)nt * 128 * 1024;
  f32x16 acc[2][2];
  gemm_core(A, B, 1024, acc, lds);
  float* stage = (float*)lds;
  bf16_t* O = (bf16_t*)(p.ws + WS_O);
#pragma unroll 1
  for (int half = 0; half < 2; ++half) {
    __syncthreads();
    if (wr == half) {
#pragma unroll
      for (int mi = 0; mi < 2; ++mi)
#pragma unroll
        for (int ni = 0; ni < 2; ++ni)
#pragma unroll
          for (int i = 0; i < 16; ++i)
            stage[(mi * 32 + (i & 3) + 8 * (i >> 2) + 4 * hh) * 132 + wc * 64 + ni * 32 + r31] = acc[mi][ni][i];
    }
    __syncthreads();
    const int row = tid >> 2, cc = tid & 3;
    float v[32];
#pragma unroll
    for (int j = 0; j < 8; ++j) {
      const f32x4 a = *(const f32x4*)(stage + row * 132 + cc * 32 + j * 4);
#pragma unroll
      for (int e = 0; e < 4; ++e) v[j * 4 + e] = a[e];
    }
    u32x4* d = (u32x4*)(O + (size_t)(mt * 128 + half * 64 + row) * 1024 + nt * 128 + cc * 32);
#pragma unroll
    for (int j = 0; j < 4; ++j) d[j] = (u32x4){pk2(v[j * 8], v[j * 8 + 1]), pk2(v[j * 8 + 2], v[j * 8 + 3]), pk2(v[j * 8 + 4], v[j * 8 + 5]), pk2(v[j * 8 + 6], v[j * 8 + 7])};
  }
}

template <int MODE, int KS>
DI void attn_task(const Params& p, int l, int kind, int b, int head, int qt, int sub, int rotn, int rotd, unsigned char* lds) {
  constexpr int NKC = MODE == 0 ? 2 : 1;
  constexpr int DV = MODE == 0 ? 128 : 64;
  constexpr int NT = DV / 32;
  constexpr int NKT = KS ? 1 : 2;
  constexpr int NG = KS ? 2 : 4;
  constexpr int KCH = NKC * 2;
  constexpr int VCH = DV / 32;
  constexpr int VOFF = NKC * 8192;
  constexpr int STAGE = VOFF + DV * 128;
  constexpr float SC = 0.18033688011112042f;
  constexpr float DEFER_RAW = 8.0f / SC;
  const int tid = opaque_tid(), lane = tid & 63, w = tid >> 6, r31 = lane & 31, hh = lane >> 5;
  const int kh = KS ? (w & 1) : 0;
  const int hq = (MODE == 1) ? (KS ? head * 4 + sub * 2 + (w >> 1) : head * 4 + w) : 0;
  const int li = l >> 1;
  const bf16_t* qkv = (const bf16_t*)(p.ws + WS_QKV);
  bf16_t* mix = (bf16_t*)(p.ws + WS_MIX);
  bool samp, isD = false; int q0, tok0, T;
  const bf16_t *k0p = nullptr, *k1p, *v0p = nullptr, *v1p; int ks0 = 0, ks1, vs0 = 0, vs1;
  int nt0 = 0, t1lo = 0, t1hi; bool windowed = false, has_sink = false; float sinkv = 0.f;
  if (MODE == 0) {
    samp = (kind == 0);
    q0 = qt * (KS ? 32 : 64);
    if (samp) { tok0 = NP + b * 1024; T = 1024; } else { tok0 = b * 256; T = 256; }
    k1p = qkv + (size_t)tok0 * 3072 + 1536 + head * 128; ks1 = 3072;
    const bf16_t* vt = (const bf16_t*)(p.ws + WS_VT);
    v1p = vt + (samp ? (size_t)NP * 512 + ((size_t)b * 512 + head * 128) * 1024 : ((size_t)b * 512 + head * 128) * 256); vs1 = T;
    t1hi = T >> 6;
    if (samp) {
      nt0 = 8;
      k0p = (const bf16_t*)(p.ws + WS_CBK) + ((size_t)(b * 2 + li) * 512) * 512 + head * 128; ks0 = 512;
      v0p = (const bf16_t*)(p.ws + WS_CBV) + ((size_t)(b * 2 + li) * 512 + head * 128) * 512; vs0 = 512;
    }
  } else {
    isD = kind & 1; samp = kind < 2;
    q0 = qt * 32;
    if (samp) { tok0 = NP + b * 1024; T = 1024; } else { tok0 = b * 256; T = 256; }
    k1p = qkv + (size_t)tok0 * 2560 + (isD ? 1792 : 512) + head * 64; ks1 = 2560;
    const bf16_t* vt = (const bf16_t*)(p.ws + (isD ? WS_VTD : WS_VT));
    v1p = vt + (samp ? (size_t)NP * 128 + ((size_t)b * 128 + head * 64) * 1024 : ((size_t)b * 128 + head * 64) * 256); vs1 = T;
    t1hi = T >> 6;
    if (samp) {
      nt0 = 8;
      k0p = (const bf16_t*)(p.ws + (isD ? WS_CDK : WS_CCK)) + ((size_t)(b * 2 + li) * 512) * 128 + head * 64; ks0 = 128;
      v0p = (const bf16_t*)(p.ws + (isD ? WS_CDV : WS_CCV)) + ((size_t)(b * 2 + li) * 128 + head * 64) * 512; vs0 = 512;
    }
    if (isD) {
      has_sink = true; sinkv = p.in[25][li * 8 + hq];
      if (samp) { windowed = true; const int lo = q0 - 128, hi = q0 + 159; t1lo = (lo < 0 ? 0 : lo) >> 6; t1hi = ((hi > 1023 ? 1023 : hi) >> 6) + 1; }
    }
  }
  const int qrow = (MODE == 0 && !KS) ? q0 + 32 * (w & 1) + r31 : q0 + r31;
  const bf16_t* qp = (MODE == 0) ? qkv + (size_t)(tok0 + qrow) * 3072 + 1024 + head * 128 + (w >> 1) * 64
                                 : qkv + (size_t)(tok0 + qrow) * 2560 + (isD ? 1280 : 0) + hq * 64;
  bf16x8 qf[4];
#pragma unroll
  for (int ks = 0; ks < 4; ++ks) qf[ks] = *(const bf16x8*)(qp + ks * 16 + hh * 8);
  const int koff = (MODE == 0) ? (w >> 1) * 8192 : 0;
  const int nst = nt0 + (t1hi - t1lo);
  const int rot = (rotn * nst) / rotd;
  const int swz = (r31 >> 1) & 7;

  u32x4 rk[KCH], rv[VCH];
  auto gload = [&](int i) {
    int st = i + rot; if (st >= nst) st -= nst;
    const bf16_t* kp; int kst; const bf16_t* vp; int vst; int key0;
    if (st < nt0) { kp = k0p; kst = ks0; vp = v0p; vst = vs0; key0 = st * 64; }
    else { kp = k1p; kst = ks1; vp = v1p; vst = vs1; key0 = (t1lo + st - nt0) * 64; }
#pragma unroll
    for (int j = 0; j < KCH; ++j) {
      const int c = tid + 256 * j;
      const int key = (NKC == 2) ? (c >> 4) : (c >> 3), cc = (NKC == 2) ? (c & 15) : (c & 7);
      rk[j] = *(const u32x4*)(kp + (size_t)(key0 + key) * kst + cc * 8);
    }
#pragma unroll
    for (int j = 0; j < VCH; ++j) {
      const int c = tid + 256 * j, dv = c >> 3, ch = c & 7;
      rv[j] = *(const u32x4*)(vp + (size_t)dv * vst + key0 + ch * 8);
    }
  };
  auto lstore = [&](int buf) {
    unsigned char* base = lds + buf * STAGE;
#pragma unroll
    for (int j = 0; j < KCH; ++j) {
      const int c = tid + 256 * j;
      const int key = (NKC == 2) ? (c >> 4) : (c >> 3), cc = (NKC == 2) ? (c & 15) : (c & 7);
      const int sub = cc >> 3, ch = cc & 7;
      *(u32x4*)(base + sub * 8192 + key * 128 + ((ch ^ ((key >> 1) & 7)) << 4)) = rk[j];
    }
#pragma unroll
    for (int j = 0; j < VCH; ++j) {
      const int c = tid + 256 * j, dv = c >> 3, ch = c & 7;
      *(u32x4*)(base + VOFF + dv * 128 + ((ch ^ ((dv >> 1) & 7)) << 4)) = rv[j];
    }
  };

  f32x16 O[NT];
#pragma unroll
  for (int t = 0; t < NT; ++t)
#pragma unroll
    for (int i = 0; i < 16; ++i) O[t][i] = 0.f;
  float m = has_sink ? sinkv * 8.0f : -1e30f;
  float lsum = (has_sink && hh == 0 && kh == 0) ? 1.0f : 0.f;

  __syncthreads();
  gload(0); lstore(0);
  if (nst > 1) gload(1);
  __syncthreads();
  for (int it = 0; it < nst; ++it) {
    if (it + 1 < nst) lstore((it + 1) & 1);
    if (it + 2 < nst) gload(it + 2);
    __builtin_amdgcn_sched_barrier(0);
    const unsigned char* ksub = lds + (it & 1) * STAGE + koff;
    const unsigned char* vsub = lds + (it & 1) * STAGE + VOFF;
    f32x16 s[NKT];
    {
      bf16x8 kf[NKT][4];
#pragma unroll
      for (int ks = 0; ks < 4; ++ks)
#pragma unroll
        for (int kt = 0; kt < NKT; ++kt) kf[kt][ks] = *(const bf16x8*)(ksub + ((KS ? kh : kt) * 32 + r31) * 128 + (((ks * 2 + hh) ^ swz) << 4));
      __builtin_amdgcn_sched_barrier(0);
      __builtin_amdgcn_s_setprio(1);
#pragma unroll
      for (int kt = 0; kt < NKT; ++kt)
#pragma unroll
        for (int i = 0; i < 16; ++i) s[kt][i] = 0.f;
#pragma unroll
      for (int ks = 0; ks < 4; ++ks)
#pragma unroll
        for (int kt = 0; kt < NKT; ++kt) s[kt] = mfma32(kf[kt][ks], qf[ks], s[kt]);
      __builtin_amdgcn_s_setprio(0);
    }
    bf16x8 vf[2][NT];
#pragma unroll
    for (int t = 0; t < NT; ++t) vf[0][t] = *(const bf16x8*)(vsub + (t * 32 + r31) * 128 + (((kh * 4 + hh) ^ swz) << 4));
    if (MODE == 1 && windowed) {
      int st = it + rot; if (st >= nst) st -= nst;
      if (st >= nt0) {
        const int key0 = (t1lo + st - nt0) * 64, qpos = q0 + r31;
#pragma unroll
        for (int kt = 0; kt < NKT; ++kt)
#pragma unroll
          for (int i = 0; i < 16; ++i) {
            const int kpos = key0 + (KS ? kh : kt) * 32 + (i & 3) + 8 * (i >> 2) + 4 * hh;
            const int d = qpos - kpos;
            if (d > 128 || d < -128) s[kt][i] = -1e30f;
          }
      }
    }
    float mx = s[0][0];
#pragma unroll
    for (int kt = 0; kt < NKT; ++kt)
#pragma unroll
      for (int i = 0; i < 16; ++i) mx = fmaxf(mx, s[kt][i]);
    { const auto sw = __builtin_amdgcn_permlane32_swap(__float_as_uint(mx), __float_as_uint(mx), false, false);
      mx = fmaxf(__uint_as_float(sw[0]), __uint_as_float(sw[1])); }
    if (__any(mx > m + DEFER_RAW)) {
      const float mnew = fmaxf(m, mx);
      const float alpha = __builtin_amdgcn_exp2f((m - mnew) * SC);
      m = mnew;
      lsum *= alpha;
#pragma unroll
      for (int t = 0; t < NT; ++t)
#pragma unroll
        for (int i = 0; i < 16; ++i) O[t][i] *= alpha;
    }
    const float mc = m * SC;
    f32x2 ps2 = {0.f, 0.f};
#pragma unroll
    for (int kt = 0; kt < NKT; ++kt)
#pragma unroll
      for (int i = 0; i < 16; i += 2) {
        const f32x2 sv = {s[kt][i], s[kt][i + 1]};
        const f32x2 tv = sv * SC - mc;
        f32x2 ev; ev.x = __builtin_amdgcn_exp2f(tv.x); ev.y = __builtin_amdgcn_exp2f(tv.y);
        s[kt][i] = ev.x; s[kt][i + 1] = ev.y;
        ps2 += ev;
      }
    lsum += ps2.x + ps2.y;
#pragma unroll
    for (int g = 0; g < NG; ++g) {
      const int kt = KS ? 0 : (g >> 1), sx = g & 1;
      if (g < NG - 1) {
#pragma unroll
        for (int t = 0; t < NT; ++t) vf[(g + 1) & 1][t] = *(const bf16x8*)(vsub + (t * 32 + r31) * 128 + ((((kh * 2 + g + 1) * 2 + hh) ^ swz) << 4));
      }
      __builtin_amdgcn_sched_barrier(0);
      u32x4 pw = {pk2(s[kt][8 * sx + 0], s[kt][8 * sx + 1]), pk2(s[kt][8 * sx + 2], s[kt][8 * sx + 3]),
                  pk2(s[kt][8 * sx + 4], s[kt][8 * sx + 5]), pk2(s[kt][8 * sx + 6], s[kt][8 * sx + 7])};
      const bf16x8 pf = __builtin_bit_cast(bf16x8, pw);
#pragma unroll
      for (int t = 0; t < NT; ++t) O[t] = mfma32(vf[g & 1][t], pf, O[t]);
      __builtin_amdgcn_sched_barrier(0);
    }
    __syncthreads();
  }
  float* X = (float*)lds;
  if (KS) {
    constexpr int RS = NT * 16 + 2;
    const int pi = w >> 1;
    if (kh == 1) {
#pragma unroll
      for (int t = 0; t < NT; ++t)
#pragma unroll
        for (int i = 0; i < 16; ++i) X[((pi * RS + t * 16 + i) << 6) + lane] = O[t][i];
      X[((pi * RS + NT * 16) << 6) + lane] = m;
      X[((pi * RS + NT * 16 + 1) << 6) + lane] = lsum;
    }
    __syncthreads();
    if (kh == 0) {
      const float m1 = X[((pi * RS + NT * 16) << 6) + lane], l1 = X[((pi * RS + NT * 16 + 1) << 6) + lane];
      const float mm = fmaxf(m, m1);
      const float a0 = __builtin_amdgcn_exp2f((m - mm) * SC), a1 = __builtin_amdgcn_exp2f((m1 - mm) * SC);
#pragma unroll
      for (int t = 0; t < NT; ++t)
#pragma unroll
        for (int i = 0; i < 16; ++i) O[t][i] = O[t][i] * a0 + X[((pi * RS + t * 16 + i) << 6) + lane] * a1;
      lsum = lsum * a0 + l1 * a1;
    }
    __syncthreads();
  }
  const float ltot = lsum + __shfl_xor(lsum, 32);
  const float inv = 1.0f / ltot;
  const int tok = tok0 + qrow;
  if (MODE == 1) {
    if (kh == 0) {
      const bf16_t* zp = qkv + (size_t)tok * 2560 + (isD ? 2048 : 768) + hq * 64;
      bf16_t* op = mix + (size_t)tok * 1024 + (isD ? 512 : 0) + hq * 64;
#pragma unroll
      for (int t = 0; t < NT; ++t)
#pragma unroll
        for (int i4 = 0; i4 < 4; ++i4) {
          const int dv0 = t * 32 + 8 * i4 + 4 * hh;
          const u32x2 z = *(const u32x2*)(zp + dv0);
          u32x2 o = {pk2(O[t][4 * i4] * inv * bf_lo(z[0]), O[t][4 * i4 + 1] * inv * bf_hi(z[0])),
                     pk2(O[t][4 * i4 + 2] * inv * bf_lo(z[1]), O[t][4 * i4 + 3] * inv * bf_hi(z[1]))};
          *(u32x2*)(op + dv0) = o;
        }
    }
  } else {
    const float* lv = p.in[19] + li * 256;
    float d1 = wave_sum(lv[lane] * lv[64 + lane]), d2 = wave_sum(lv[128 + lane] * lv[192 + lane]);
    const float lam_init = (l == 0) ? 0.2f : 0.47071301834358416f;
    const float lam = expf(d1) - expf(d2) + lam_init;
    const int xr = KS ? 0 : (w & 1) * 64;
    if (w >= 2 && kh == 0) {
#pragma unroll
      for (int t = 0; t < NT; ++t)
#pragma unroll
        for (int i = 0; i < 16; ++i) X[((xr + t * 16 + i) << 6) + lane] = O[t][i] * inv;
    }
    __syncthreads();
    if (w < 2 && kh == 0) {
      float ss = 0.f;
#pragma unroll
      for (int t = 0; t < NT; ++t)
#pragma unroll
        for (int i = 0; i < 16; ++i) { const float o = O[t][i] * inv - lam * X[((xr + t * 16 + i) << 6) + lane]; O[t][i] = o; ss += o * o; }
      ss += __shfl_xor(ss, 32);
      const float scale = rsqrtf(ss * (1.0f / 128.0f) + EPS) * (1.0f - lam_init);
      const float* sg = p.in[20] + li * 128;
      const bf16_t* zp = qkv + (size_t)tok * 3072 + 2560 + head * 128;
      bf16_t* op = mix + (size_t)tok * 1024 + 512 + head * 128;
#pragma unroll
      for (int t = 0; t < NT; ++t)
#pragma unroll
        for (int i4 = 0; i4 < 4; ++i4) {
          const int dv0 = t * 32 + 8 * i4 + 4 * hh;
          const u32x2 z = *(const u32x2*)(zp + dv0);
          const f32x4 g = *(const f32x4*)(sg + dv0);
          u32x2 o = {pk2(O[t][4 * i4] * scale * g[0] * bf_lo(z[0]), O[t][4 * i4 + 1] * scale * g[1] * bf_hi(z[0])),
                     pk2(O[t][4 * i4 + 2] * scale * g[2] * bf_lo(z[1]), O[t][4 * i4 + 3] * scale * g[3] * bf_hi(z[1]))};
          *(u32x2*)(op + dv0) = o;
        }
    }
  }
}

DI void conv_task(const Params& p, int l, int tile, unsigned char* lds) {
  const int tid = opaque_tid(), lane = tid & 63, w = tid >> 6;
  const int li = l >> 1;
  const bf16_t* qkv = (const bf16_t*)(p.ws + WS_QKV);
  bf16_t* mix = (bf16_t*)(p.ws + WS_MIX);
  const int t0 = tile * 32;
  const int seq_lo = t0 < NP ? (t0 & ~255) : NP + ((t0 - NP) & ~1023);
  const int seq_hi = seq_lo + (t0 < NP ? 256 : 1024);
  __syncthreads();
  {
    u32x4 v[16];
#pragma unroll
    for (int i = 0; i < 16; ++i) {
      const int c = tid + 256 * i, rr = c >> 6, ch = c & 63, tk = t0 - 15 + rr;
      v[i] = (u32x4){0u, 0u, 0u, 0u};
      if (c < 62 * 64 && tk >= seq_lo && tk < seq_hi) v[i] = *(const u32x4*)(qkv + (size_t)tk * 3072 + ch * 8);
    }
#pragma unroll
    for (int i = 0; i < 16; ++i) {
      const int c = tid + 256 * i, rr = c >> 6, ch = c & 63;
      if (c < 62 * 64) *(u32x4*)(lds + rr * 1024 + ch * 16) = v[i];
    }
  }
  __syncthreads();
  const float* cw = p.in[15] + (size_t)li * 31 * 512;
  const float* cb = p.in[16] + li * 512;
  const float* lg = p.in[17] + li * 512;
  const float* lb = p.in[18] + li * 512;
  float sum[8], sq[8];
#pragma unroll
  for (int tt = 0; tt < 8; ++tt) { sum[tt] = 0.f; sq[tt] = 0.f; }
#pragma unroll 1
  for (int pz = 0; pz < 4; ++pz) {
    const int ch = pz * 128 + lane * 2;
    f32x2 wv[31];
#pragma unroll
    for (int j = 0; j < 31; ++j) wv[j] = *(const f32x2*)(cw + j * 512 + ch);
    const f32x2 bias = *(const f32x2*)(cb + ch);
    float r[8][2];
#pragma unroll
    for (int tt = 0; tt < 8; ++tt) { r[tt][0] = bias[0]; r[tt][1] = bias[1]; }
#pragma unroll
    for (int rr = 0; rr < 38; ++rr) {
      const unsigned xv = *(const unsigned*)(lds + (w * 8 + rr) * 1024 + ch * 2);
      const float x0 = bf_lo(xv), x1 = bf_hi(xv);
#pragma unroll
      for (int tt = 0; tt < 8; ++tt) {
        const int j = rr - tt;
        if (j >= 0 && j < 31) { r[tt][0] += wv[j][0] * x0; r[tt][1] += wv[j][1] * x1; }
      }
    }
#pragma unroll
    for (int tt = 0; tt < 8; ++tt) {
      sum[tt] += r[tt][0] + r[tt][1]; sq[tt] += r[tt][0] * r[tt][0] + r[tt][1] * r[tt][1];
      *(unsigned*)(mix + (size_t)(t0 + w * 8 + tt) * 1024 + ch) = pk2(r[tt][0], r[tt][1]);
    }
  }
#pragma unroll
  for (int tt = 0; tt < 8; ++tt) {
    const float mu = wave_sum(sum[tt]) * (1.0f / 512.0f);
    const float var = wave_sum(sq[tt]) * (1.0f / 512.0f) - mu * mu;
    sum[tt] = mu; sq[tt] = rsqrtf(fmaxf(var, 0.f) + EPS);
  }
#pragma unroll 1
  for (int pz = 0; pz < 4; ++pz) {
    const int ch = pz * 128 + lane * 2;
    const f32x2 g = *(const f32x2*)(lg + ch), bb = *(const f32x2*)(lb + ch);
    unsigned rv[8], zv[8];
#pragma unroll
    for (int tt = 0; tt < 8; ++tt) {
      const int tok = t0 + w * 8 + tt;
      rv[tt] = *(const unsigned*)(mix + (size_t)tok * 1024 + ch);
      zv[tt] = *(const unsigned*)(qkv + (size_t)tok * 3072 + 512 + ch);
    }
#pragma unroll
    for (int tt = 0; tt < 8; ++tt) {
      const int tok = t0 + w * 8 + tt;
      float y0 = (bf_lo(rv[tt]) - sum[tt]) * sq[tt] * g[0] + bb[0], y1 = (bf_hi(rv[tt]) - sum[tt]) * sq[tt] * g[1] + bb[1];
      y0 = y0 * sigmoidf_(y0) * bf_lo(zv[tt]); y1 = y1 * sigmoidf_(y1) * bf_hi(zv[tt]);
      *(unsigned*)(mix + (size_t)tok * 1024 + ch) = pk2(y0, y1);
    }
  }
}

DI void phase_mix(const Params& p, int l, unsigned char* lds) {
  const bool odd = l & 1;
  const int ntask = odd ? 768 : 704;
  const int G = gridDim.x, bid = blockIdx.x;
  for (int r = 0;; ++r) {
    if (r * G >= ntask) break;
    const int t = r * G + ((r & 1) ? (G - 1 - bid) : bid);
    if (t >= ntask) continue;
    if (!odd) {
      if (t < 256) { const int x = t & 7, j = t >> 3; attn_task<0, 1>(p, l, 0, x >> 2, x & 3, j, 0, j, 32, lds); }
      else if (t < 448) conv_task(p, l, t - 256, lds);
      else { const int u = t - 448, x = u & 7, j = u >> 3, sm = (j >> 2) * 8 + x; attn_task<0, 0>(p, l, 1, sm >> 2, sm & 3, j & 3, 0, j & 3, 4, lds); }
    } else {
      if (t < 256) { const int u = t & 127, x = u & 7, j = u >> 3, sm = x & 3; attn_task<1, 0>(p, l, t >> 7, sm >> 1, sm & 1, (x >> 2) * 16 + j, 0, j, 16, lds); }
      else { const int u = (t - 256) & 255, x = u & 7, j = u >> 3, sm = (j >> 3) * 8 + x; attn_task<1, 0>(p, l, 2 + ((t - 256) >> 8), sm >> 1, sm & 1, j & 7, 0, j & 7, 8, lds); }
    }
  }
}

constexpr int LDS_BYTES = 65536 + 64;
__global__ void __launch_bounds__(256, 2) mega(Params p, int ph_lo, int ph_hi) {
  extern __shared__ __attribute__((aligned(16))) unsigned char lds[];
  cg::grid_group grid = cg::this_grid();
  if (ph_lo > 1000) grid.sync();
  volatile LAS unsigned* st = (volatile LAS unsigned*)(lds + 65536);
  if (threadIdx.x == 0) { st[0] = 0u; st[1] = 0u; }
  __syncthreads();
  const XcdBarrier xb = xcd_barrier_post((unsigned*)(p.ws + WS_BAR), st);
  for (int ph = ph_lo; ph < ph_hi; ++ph) {
    if (ph == 0) phase_prep(p, lds);
    else if (ph == 1) phase_post(p, -1, 0);
    else {
      const int l = (ph - 2) >> 2, sub = (ph - 2) & 3;
      if (sub == 0) { const int nt = (l & 1) ? 48 * 20 : 48 * 28; for (int t = blockIdx.x; t < nt; t += gridDim.x) gemm_in_tile(p, l, t, lds); }
      else if (sub == 1) phase_mix(p, l, lds);
      else if (sub == 2) { for (int t = blockIdx.x; t < 384; t += gridDim.x) gemm_out_tile(p, l, t, lds); }
      else phase_post(p, l, l + 1);
    }
    if (ph + 1 < ph_hi) xcd_barrier(xb);
  }
}

#ifndef PER_PHASE_LAUNCH
#define PER_PHASE_LAUNCH 0
#endif

extern "C" void kernel_launch(void* const* d_in, const int* in_sizes, int n_in, void* d_out, int out_size, void* d_ws, size_t ws_size, hipStream_t stream) {
  static int grid_blocks = 0;
  if (!grid_blocks) {
    int dev = 0, cus = 0, per_cu = 0;
    (void)hipGetDevice(&dev);
    (void)hipDeviceGetAttribute(&cus, hipDeviceAttributeMultiprocessorCount, dev);
    (void)hipFuncSetAttribute((const void*)mega, hipFuncAttributeMaxDynamicSharedMemorySize, LDS_BYTES);
    (void)hipOccupancyMaxActiveBlocksPerMultiprocessor(&per_cu, mega, 256, LDS_BYTES);
    if (per_cu < 1) per_cu = 1;
    if (per_cu > 2) per_cu = 2;
    grid_blocks = cus * per_cu;
    if (n_in != 27 || ws_size < WS_END) fprintf(stderr, "kernel_launch: unexpected n_in %d / ws %zu\n", n_in, ws_size);
  }
  (void)hipMemsetAsync(d_ws, 0, 16384, stream);
  Params p{};
  for (int i = 0; i < 27; ++i) p.in[i] = (const float*)d_in[i];
  p.out = (float*)d_out; p.ws = (unsigned char*)d_ws;
#if PER_PHASE_LAUNCH
  for (int ph = 0; ph < NPHASE; ++ph) hipLaunchKernelGGL(mega, dim3(grid_blocks), dim3(256), LDS_BYTES, stream, p, ph, ph + 1);
#else
  int lo = 0, hi = NPHASE;
  void* args[] = {&p, &lo, &hi};
  hipError_t e = hipLaunchCooperativeKernel((void*)mega, dim3(grid_blocks), dim3(256), args, LDS_BYTES, stream);
  if (e != hipSuccess) fprintf(stderr, "cooperative launch failed: %s (grid %d)\n", hipGetErrorString(e), grid_blocks);
#endif
}
```

```cpp
#include <hip/hip_runtime.h>
#include <hip/hip_cooperative_groups.h>
#include <cstdio>
#include <cstdint>
namespace cg = cooperative_groups;

#define DI __device__ __forceinline__
typedef unsigned short bf16_t;
typedef short bf16x8 __attribute__((ext_vector_type(8)));
typedef short s16x4 __attribute__((ext_vector_type(4)));
typedef float f32x16 __attribute__((ext_vector_type(16)));
typedef float f32x4 __attribute__((ext_vector_type(4)));
typedef float f32x2 __attribute__((ext_vector_type(2)));
typedef unsigned u32x4 __attribute__((ext_vector_type(4)));
typedef unsigned u32x2 __attribute__((ext_vector_type(2)));
typedef __bf16 bf2_t __attribute__((ext_vector_type(2)));

DI unsigned pk2(float lo, float hi) { f32x2 v = {lo, hi}; return __builtin_bit_cast(unsigned, __builtin_convertvector(v, bf2_t)); }
DI float bf_lo(unsigned u) { return __uint_as_float(u << 16); }
DI float bf_hi(unsigned u) { return __uint_as_float(u & 0xffff0000u); }
DI f32x16 mfma32(bf16x8 a, bf16x8 b, f32x16 c) { return __builtin_amdgcn_mfma_f32_32x32x16_bf16(a, b, c, 0, 0, 0); }
DI float sigmoidf_(float x) { return __builtin_amdgcn_rcpf(1.0f + __expf(-x)); }
DI int opaque_tid() { int t = threadIdx.x; asm volatile("" : "+v"(t)); return t; }
template <int CTRL> DI float dpp_f(float v) { return __builtin_bit_cast(float, __builtin_amdgcn_update_dpp(0, __builtin_bit_cast(int, v), CTRL, 0xF, 0xF, true)); }
DI float wave_sum(float v) {
  v += dpp_f<0xB1>(v);
  v += dpp_f<0x4E>(v);
  v += dpp_f<0x141>(v);
  v += dpp_f<0x140>(v);
  v += __shfl_xor(v, 16);
  const auto sw = __builtin_amdgcn_permlane32_swap(__float_as_uint(v), __float_as_uint(v), false, false);
  return __uint_as_float(sw[0]) + __uint_as_float(sw[1]);
}

constexpr int NTOK = 6144, NP = 4096;
constexpr float EPS = 1e-6f;
constexpr size_t OFF_NBK = 6291456, OFF_NBV = 10485760, OFF_NCK = 14680064, OFF_NCV = 15728640, OFF_NDK = 16777216, OFF_NDV = 17825792;
constexpr size_t WS_CTR = 0;
constexpr size_t WS_BAR = 1024;
constexpr size_t WS_MOD = 16384;
constexpr size_t WS_WIE = WS_MOD + 147456;
constexpr size_t WS_WOE = WS_WIE + 14680064;
constexpr size_t WS_WIO = WS_WOE + 4194304;
constexpr size_t WS_WOO = WS_WIO + 10485760;
constexpr size_t WS_CBK = WS_WOO + 4194304;
constexpr size_t WS_CBV = WS_CBK + 2097152;
constexpr size_t WS_CCK = WS_CBV + 2097152;
constexpr size_t WS_CCV = WS_CCK + 524288;
constexpr size_t WS_CDK = WS_CCV + 524288;
constexpr size_t WS_CDV = WS_CDK + 524288;
constexpr size_t WS_H = WS_CDV + 524288;
constexpr size_t WS_QKV = WS_H + 12582912;
constexpr size_t WS_VT = WS_QKV + 37748736;
constexpr size_t WS_VTD = WS_VT + 1572864;
constexpr size_t WS_MIX = WS_VT + 6291456;
constexpr size_t WS_O = WS_MIX + 12582912;
constexpr size_t WS_END = WS_O + 25165824;

struct Params {
  const float* in[27];
  float* out;
  unsigned char* ws;
};

constexpr int NPHASE = 18;


#define XB_TMO      128
#define XB_XCNT(j)  (256  + 64 * (j))
#define XB_XSUB(j)  (1280 + 64 * (j))
#define XB_XGEN(j)  (2304 + 64 * (j))
#define XB_TOP      3328
#define XB_TOPGEN   3392
#define XCD_BAR_WORDS 3456
#define XB_SPIN_CAP (1u << 18)
#define LAS __attribute__((address_space(3)))
DI unsigned xb_ld(unsigned* p) { return __hip_atomic_load(p, __ATOMIC_RELAXED, __HIP_MEMORY_SCOPE_AGENT); }
DI unsigned xb_add(unsigned* p, unsigned v) { return __hip_atomic_fetch_add(p, v, __ATOMIC_RELAXED, __HIP_MEMORY_SCOPE_AGENT); }
DI unsigned xb_xcc_id() { return (unsigned)__builtin_amdgcn_s_getreg((3 << 11) | 20) & 0xFu; }
#define XB_SPIN(cond, bar) do { unsigned _sp = 0; while (cond) { __builtin_amdgcn_s_sleep(1); \
    if ((++_sp & 255u) == 0u) { if (xb_ld(&(bar)[XB_TMO])) break; if (_sp > XB_SPIN_CAP) { atomicAdd(&(bar)[XB_TMO], 1u); break; } } } } while (0)
struct XcdBarrier { unsigned* bar; unsigned x; volatile LAS unsigned* st; };
DI XcdBarrier xcd_barrier_post(unsigned* bar, volatile LAS unsigned* st) {
  XcdBarrier b; b.bar = bar; b.x = xb_xcc_id(); b.st = st;
  if (threadIdx.x == 0) (void)xb_add(&bar[XB_XCNT(b.x)], 1u);
  return b;
}
DI void xcd_barrier_complete(unsigned* bar, unsigned x, unsigned& nloc, unsigned& nx) {
  const unsigned G = gridDim.x * gridDim.y * gridDim.z;
  unsigned sum, cnt, mine, sp = 0u;
  for (;;) {
    sum = 0u; cnt = 0u; mine = 0u;
#pragma unroll
    for (unsigned j = 0; j < 16; ++j) { const unsigned c = xb_ld(&bar[XB_XCNT(j)]); sum += c; cnt += (c > 0u) ? 1u : 0u; mine = (j == x) ? c : mine; }
    if (sum == G) break;
    __builtin_amdgcn_s_sleep(1);
    if ((++sp & 255u) == 0u) { if (xb_ld(&bar[XB_TMO])) break; if (sp > XB_SPIN_CAP) { atomicAdd(&bar[XB_TMO], 1u); break; } }
  }
  nloc = mine > 0u ? mine : 1u; nx = cnt > 0u ? cnt : 1u;
}
DI void xcd_barrier(const XcdBarrier& b) {
  asm volatile("s_waitcnt vmcnt(0)" ::: "memory");
  __syncthreads();
  if (threadIdx.x == 0) {
    unsigned* bar = b.bar;
    __builtin_amdgcn_s_waitcnt(0);
    unsigned nloc = b.st[0], nx = b.st[1];
    if (nloc == 0u) { xcd_barrier_complete(bar, b.x, nloc, nx); b.st[0] = nloc; b.st[1] = nx; }
    const unsigned old = xb_add(&bar[XB_XSUB(b.x)], 1u);
    const unsigned gen = old / nloc;
    if (old + 1u == (gen + 1u) * nloc) {
      __builtin_amdgcn_fence(__ATOMIC_RELEASE, "agent");
      asm volatile("s_waitcnt vmcnt(0)" ::: "memory");
      const unsigned og = xb_add(&bar[XB_TOP], 1u);
      const unsigned tg = og / nx;
      if (og + 1u == (tg + 1u) * nx) xb_add(&bar[XB_TOPGEN], 1u);
      else XB_SPIN(xb_ld(&bar[XB_TOPGEN]) == tg, bar);
      __builtin_amdgcn_fence(__ATOMIC_ACQUIRE, "agent");
      xb_add(&bar[XB_XGEN(b.x)], 1u);
      asm volatile("s_waitcnt vmcnt(0)" ::: "memory");
    } else {
      XB_SPIN(xb_ld(&bar[XB_XGEN(b.x)]) == gen, bar);
      __builtin_amdgcn_fence(__ATOMIC_ACQUIRE, "agent");
      asm volatile("s_waitcnt vmcnt(0)" ::: "memory");
    }
  }
  __syncthreads();
}

template <bool PERMK>
DI void trans_tile(const float* __restrict__ src, int sstride, bf16_t* __restrict__ dst, int dstride, unsigned char* lds) {
  bf16_t* T = (bf16_t*)lds;
  const int tid = opaque_tid();
  __syncthreads();
#pragma unroll
  for (int ps = 0; ps < 4; ++ps) {
    const int ksrc = (tid >> 4) + 16 * ps, nn = (tid & 15) * 4;
    const int kk = PERMK ? ((ksrc & ~12) | ((ksrc & 4) << 1) | ((ksrc & 8) >> 1)) : ksrc;
    const f32x4 v = __builtin_nontemporal_load((const f32x4*)(src + (size_t)ksrc * sstride + nn));
    const unsigned a = pk2(v[0], v[1]), b = pk2(v[2], v[3]);
    T[(nn + 0) * 66 + kk] = (bf16_t)(a & 0xffffu);
    T[(nn + 1) * 66 + kk] = (bf16_t)(a >> 16);
    T[(nn + 2) * 66 + kk] = (bf16_t)(b & 0xffffu);
    T[(nn + 3) * 66 + kk] = (bf16_t)(b >> 16);
  }
  __syncthreads();
  const int n = tid >> 2, ch = tid & 3;
  const unsigned* Tr = (const unsigned*)(T + n * 66 + ch * 16);
  u32x4 o0 = {Tr[0], Tr[1], Tr[2], Tr[3]}, o1 = {Tr[4], Tr[5], Tr[6], Tr[7]};
  u32x4* d = (u32x4*)(dst + (size_t)n * dstride + ch * 16);
  d[0] = o0; d[1] = o1;
}

DI void conv_tile4096(const float* __restrict__ src, bf16_t* __restrict__ dst) {
  const int tid = opaque_tid();
#pragma unroll
  for (int ps = 0; ps < 4; ++ps) {
    const int e = ps * 1024 + tid * 4;
    const f32x4 v = __builtin_nontemporal_load((const f32x4*)(src + e));
    u32x2 o = {pk2(v[0], v[1]), pk2(v[2], v[3])};
    *(u32x2*)(dst + e) = o;
  }
}

DI void mod_tile(const Params& p, int t, unsigned char* lds) {
  const int l = t / 96, grp = t % 96;
  float* sc = (float*)lds;
  float* red = (float*)(lds + 12288);
  const int tid = opaque_tid();
  __syncthreads();
  for (int idx = tid; idx < 3072; idx += 256) {
    const int r = idx >> 10, k = idx & 1023;
    const float c = (r == 0) ? p.in[9][k] : p.in[8][(r - 1) * 1024 + k];
    sc[idx] = c / (1.0f + expf(-c));
  }
  __syncthreads();
  const int cg4 = tid & 7, kr = tid >> 3;
  const float* W = p.in[12] + (size_t)l * 1024 * 3072 + grp * 32 + cg4 * 4;
  f32x4 a0 = {0, 0, 0, 0}, a1 = {0, 0, 0, 0}, a2 = {0, 0, 0, 0};
#pragma unroll 8
  for (int ps = 0; ps < 32; ++ps) {
    const int k = kr + 32 * ps;
    const f32x4 wv = __builtin_nontemporal_load((const f32x4*)(W + (size_t)k * 3072));
    a0 += sc[k] * wv; a1 += sc[1024 + k] * wv; a2 += sc[2048 + k] * wv;
  }
  float* rp = red + (kr * 8 + cg4) * 12;
  *(f32x4*)(rp) = a0; *(f32x4*)(rp + 4) = a1; *(f32x4*)(rp + 8) = a2;
  __syncthreads();
  if (tid < 96) {
    const int r = tid >> 5, c = tid & 31;
    float s = 0.f;
    for (int k2 = 0; k2 < 32; ++k2) s += red[(k2 * 8 + (c >> 2)) * 12 + r * 4 + (c & 3)];
    float* mod = (float*)(p.ws + WS_MOD);
    mod[(l * 3 + r) * 3072 + grp * 32 + c] = s + p.in[13][l * 3072 + grp * 32 + c];
  }
}

DI void wdesc(const Params& p, int u, const float*& src, int& ss, bf16_t*& dst) {
  if (u < 1792) {
    const int i = u / 896, v = u % 896, kt = v & 15, dt = v >> 4;
    const int sb = dt < 16 ? ((dt & 1) ? 8 + (dt >> 1) : (dt >> 1)) : dt;
    src = p.in[14] + (size_t)i * 1024 * 3584 + (size_t)kt * 64 * 3584 + sb * 64; ss = 3584;
    dst = (bf16_t*)(p.ws + WS_WIE) + (size_t)i * 3584 * 1024 + (size_t)dt * 64 * 1024 + kt * 64;
  } else if (u < 2304) {
    u -= 1792; const int i = u >> 8, v = u & 255, kt = v & 15, dt = v >> 4;
    src = p.in[21] + (size_t)i * 1024 * 1024 + (size_t)kt * 64 * 1024 + dt * 64; ss = 1024;
    dst = (bf16_t*)(p.ws + WS_WOE) + (size_t)i * 1024 * 1024 + (size_t)dt * 64 * 1024 + kt * 64;
  } else if (u < 3584) {
    u -= 2304; const int i = u / 640, v = u % 640, kt = v & 15, dt = v >> 4;
    src = p.in[22] + (size_t)i * 1024 * 2560 + (size_t)kt * 64 * 2560 + dt * 64; ss = 2560;
    dst = (bf16_t*)(p.ws + WS_WIO) + (size_t)i * 2560 * 1024 + (size_t)dt * 64 * 1024 + kt * 64;
  } else {
    u -= 3584; const int i = u >> 8, v = u & 255, kt = v & 15, dt = v >> 4;
    src = p.in[26] + (size_t)i * 1024 * 1024 + (size_t)kt * 64 * 1024 + dt * 64; ss = 1024;
    dst = (bf16_t*)(p.ws + WS_WOO) + (size_t)i * 1024 * 1024 + (size_t)dt * 64 * 1024 + kt * 64;
  }
}
DI void phase_prep(const Params& p, unsigned char* lds) {
  const int tid = opaque_tid();
  for (int t = blockIdx.x; t < 384; t += gridDim.x) mod_tile(p, t, lds);
  {
    bf16_t* T = (bf16_t*)lds;
    f32x4 cur[4], nxt[4];
    const float* src; int ss; bf16_t* dst;
    int u = blockIdx.x;
    if (u < 4096) {
      wdesc(p, u, src, ss, dst);
#pragma unroll
      for (int ps = 0; ps < 4; ++ps) cur[ps] = __builtin_nontemporal_load((const f32x4*)(src + (size_t)((tid >> 4) + 16 * ps) * ss + (tid & 15) * 4));
    }
    while (u < 4096) {
      const int un = u + gridDim.x;
      bf16_t* dcur = dst;
      if (un < 4096) {
        wdesc(p, un, src, ss, dst);
#pragma unroll
        for (int ps = 0; ps < 4; ++ps) nxt[ps] = __builtin_nontemporal_load((const f32x4*)(src + (size_t)((tid >> 4) + 16 * ps) * ss + (tid & 15) * 4));
      }
      __builtin_amdgcn_sched_barrier(0);
      __syncthreads();
#pragma unroll
      for (int ps = 0; ps < 4; ++ps) {
        const int kk = (tid >> 4) + 16 * ps, nn = (tid & 15) * 4;
        const unsigned a = pk2(cur[ps][0], cur[ps][1]), b2 = pk2(cur[ps][2], cur[ps][3]);
        T[(nn + 0) * 66 + kk] = (bf16_t)(a & 0xffffu);
        T[(nn + 1) * 66 + kk] = (bf16_t)(a >> 16);
        T[(nn + 2) * 66 + kk] = (bf16_t)(b2 & 0xffffu);
        T[(nn + 3) * 66 + kk] = (bf16_t)(b2 >> 16);
      }
      __syncthreads();
      {
        const int n = tid >> 2, ch = tid & 3;
        const unsigned* Tr = (const unsigned*)(T + n * 66 + ch * 16);
        u32x4 o0 = {Tr[0], Tr[1], Tr[2], Tr[3]}, o1 = {Tr[4], Tr[5], Tr[6], Tr[7]};
        u32x4* d = (u32x4*)(dcur + (size_t)n * 1024 + ch * 16);
        d[0] = o0; d[1] = o1;
      }
#pragma unroll
      for (int ps = 0; ps < 4; ++ps) cur[ps] = nxt[ps];
      u = un;
    }
  }
  for (int t = 4480 + blockIdx.x; t < 5248; t += gridDim.x) {
    if (t < 4864) {
      int u = t - 4480;
      if (u < 256) {
        const int bi = u >> 6, v = u & 63, kt = v & 7, ct = v >> 3;
        trans_tile<true>(p.in[3] + ((size_t)bi * 512 + kt * 64) * 512 + ct * 64, 512,
                   (bf16_t*)(p.ws + WS_CBV) + ((size_t)bi * 512 + ct * 64) * 512 + kt * 64, 512, lds);
      } else {
        const bool isd = u >= 320; u -= isd ? 320 : 256;
        const int bi = u >> 4, v = u & 15, kt = v & 7, ct = v >> 3;
        trans_tile<true>(p.in[isd ? 7 : 5] + ((size_t)bi * 512 + kt * 64) * 128 + ct * 64, 128,
                   (bf16_t*)(p.ws + (isd ? WS_CDV : WS_CCV)) + ((size_t)bi * 128 + ct * 64) * 512 + kt * 64, 512, lds);
      }
    } else {
      int u = t - 4864;
      if (u < 256) conv_tile4096(p.in[2] + (size_t)u * 4096, (bf16_t*)(p.ws + WS_CBK) + (size_t)u * 4096);
      else if (u < 320) conv_tile4096(p.in[4] + (size_t)(u - 256) * 4096, (bf16_t*)(p.ws + WS_CCK) + (size_t)(u - 256) * 4096);
      else conv_tile4096(p.in[6] + (size_t)(u - 320) * 4096, (bf16_t*)(p.ws + WS_CDK) + (size_t)(u - 320) * 4096);
    }
  }
}

DI void phase_post(const Params& p, int ldone, int lnext) {
  const int tid = opaque_tid(); const int lane = tid & 63, w = tid >> 6;
  const float* mod = (const float*)(p.ws + WS_MOD);
  const bf16_t* O = (const bf16_t*)(p.ws + WS_O);
  bf16_t* H = (bf16_t*)(p.ws + WS_H);
  for (int row = blockIdx.x * 4 + w; row < NTOK; row += gridDim.x * 4) {
    const int r = row < NP ? 0 : 1 + ((row - NP) >> 10);
    const float* xin = (ldone <= 0) ? (row < NP ? p.in[0] + (size_t)row * 1024 : p.in[1] + (size_t)(row - NP) * 1024) : p.out + (size_t)row * 1024;
    f32x4 x[4], gv[4], nv[4], shv[4], scv[4], npv[4]; u32x2 ov[4];
#pragma unroll
    for (int j = 0; j < 4; ++j) x[j] = *(const f32x4*)(xin + lane * 4 + 256 * j);
    if (ldone >= 0) {
      const float* g = mod + (size_t)(ldone * 3 + r) * 3072 + 2048;
      const float* np_ = p.in[11] + ldone * 1024;
#pragma unroll
      for (int j = 0; j < 4; ++j) { ov[j] = __builtin_nontemporal_load((const u32x2*)(O + (size_t)row * 1024 + lane * 4 + 256 * j)); gv[j] = *(const f32x4*)(g + lane * 4 + 256 * j); nv[j] = *(const f32x4*)(np_ + lane * 4 + 256 * j); }
    }
    if (lnext < 4) {
      const float* sh = mod + (size_t)(lnext * 3 + r) * 3072;
      const float* npre = p.in[10] + lnext * 1024;
#pragma unroll
      for (int j = 0; j < 4; ++j) { const int c = lane * 4 + 256 * j; shv[j] = *(const f32x4*)(sh + c); scv[j] = *(const f32x4*)(sh + 1024 + c); npv[j] = *(const f32x4*)(npre + c); }
    }
    __builtin_amdgcn_sched_barrier(0);
    if (ldone >= 0) {
      f32x4 o[4]; float ss = 0.f;
#pragma unroll
      for (int j = 0; j < 4; ++j) { o[j] = (f32x4){bf_lo(ov[j][0]), bf_hi(ov[j][0]), bf_lo(ov[j][1]), bf_hi(ov[j][1])}; ss += o[j][0] * o[j][0] + o[j][1] * o[j][1] + o[j][2] * o[j][2] + o[j][3] * o[j][3]; }
      ss = wave_sum(ss);
      const float rs = rsqrtf(ss * (1.0f / 1024.0f) + EPS);
#pragma unroll
      for (int j = 0; j < 4; ++j) {
        x[j] = x[j] + gv[j] * (o[j] * rs * nv[j]);
        *(f32x4*)(p.out + (size_t)row * 1024 + lane * 4 + 256 * j) = x[j];
      }
    }
    if (lnext < 4) {
      float ss = 0.f;
#pragma unroll
      for (int j = 0; j < 4; ++j) ss += x[j][0] * x[j][0] + x[j][1] * x[j][1] + x[j][2] * x[j][2] + x[j][3] * x[j][3];
      ss = wave_sum(ss);
      const float rs = rsqrtf(ss * (1.0f / 1024.0f) + EPS);
#pragma unroll
      for (int j = 0; j < 4; ++j) {
        const int c = lane * 4 + 256 * j;
        const f32x4 hv = x[j] * rs * npv[j] * (1.0f + scv[j]) + shv[j];
        u32x2 o2 = {pk2(hv[0], hv[1]), pk2(hv[2], hv[3])};
        *(u32x2*)(H + (size_t)row * 1024 + c) = o2;
      }
    }
  }
}

DI void gemm_core(const bf16_t* __restrict__ A, const bf16_t* __restrict__ B, int K, f32x16 (&acc)[2][2], unsigned char* lds) {
  const int tid = opaque_tid(), lane = tid & 63, w = tid >> 6, wr = w >> 1, wc = w & 1, r31 = lane & 31, hh = lane >> 5;
  u32x4 ra[4], rb[4];
#pragma unroll
  for (int mi = 0; mi < 2; ++mi)
#pragma unroll
    for (int ni = 0; ni < 2; ++ni)
#pragma unroll
      for (int i = 0; i < 16; ++i) acc[mi][ni][i] = 0.f;
  __syncthreads();
#pragma unroll
  for (int i = 0; i < 4; ++i) {
    const int c = tid + 256 * i, row = c >> 3, ch = c & 7;
    ra[i] = *(const u32x4*)(A + (size_t)row * K + ch * 8);
    rb[i] = *(const u32x4*)(B + (size_t)row * K + ch * 8);
  }
#pragma unroll
  for (int i = 0; i < 4; ++i) {
    const int c = tid + 256 * i, row = c >> 3, ch = c & 7, off = row * 128 + ((ch ^ ((row >> 1) & 7)) << 4);
    *(u32x4*)(lds + off) = ra[i]; *(u32x4*)(lds + 16384 + off) = rb[i];
  }
  __syncthreads();
  const int nk = K >> 6;
  for (int kt = 0; kt < nk; ++kt) {
    if (kt + 1 < nk) {
#pragma unroll
      for (int i = 0; i < 4; ++i) {
        const int c = tid + 256 * i, row = c >> 3, ch = c & 7;
        ra[i] = *(const u32x4*)(A + (size_t)row * K + (kt + 1) * 64 + ch * 8);
        rb[i] = *(const u32x4*)(B + (size_t)row * K + (kt + 1) * 64 + ch * 8);
      }
    }
    __builtin_amdgcn_sched_barrier(0);
    const unsigned char* sa = lds + (kt & 1) * 32768 + (wr * 64 + r31) * 128;
    const unsigned char* sb = lds + (kt & 1) * 32768 + 16384 + (wc * 64 + r31) * 128;
    const int sx = (r31 >> 1) & 7;
    bf16x8 af[2][2], bfr[2][2];
#pragma unroll
    for (int mi = 0; mi < 2; ++mi) af[0][mi] = *(const bf16x8*)(sa + mi * 4096 + ((hh ^ sx) << 4));
#pragma unroll
    for (int ni = 0; ni < 2; ++ni) bfr[0][ni] = *(const bf16x8*)(sb + ni * 4096 + ((hh ^ sx) << 4));
#pragma unroll
    for (int ks = 0; ks < 4; ++ks) {
      if (ks < 3) {
        const int sw = (((ks + 1) * 2 + hh) ^ sx) << 4;
#pragma unroll
        for (int mi = 0; mi < 2; ++mi) af[(ks + 1) & 1][mi] = *(const bf16x8*)(sa + mi * 4096 + sw);
#pragma unroll
        for (int ni = 0; ni < 2; ++ni) bfr[(ks + 1) & 1][ni] = *(const bf16x8*)(sb + ni * 4096 + sw);
      }
      __builtin_amdgcn_sched_barrier(0);
#pragma unroll
      for (int mi = 0; mi < 2; ++mi)
#pragma unroll
        for (int ni = 0; ni < 2; ++ni) acc[mi][ni] = mfma32(af[ks & 1][mi], bfr[ks & 1][ni], acc[mi][ni]);
      __builtin_amdgcn_sched_barrier(0);
    }
    if (kt + 1 < nk) {
      unsigned char* da = lds + ((kt + 1) & 1) * 32768;
#pragma unroll
      for (int i = 0; i < 4; ++i) {
        const int c = tid + 256 * i, row = c >> 3, ch = c & 7, off = row * 128 + ((ch ^ ((row >> 1) & 7)) << 4);
        *(u32x4*)(da + off) = ra[i]; *(u32x4*)(da + 16384 + off) = rb[i];
      }
    }
    __syncthreads();
  }
}

__device__ const float INVF[16] = {1.0f, 0.5623413252f, 0.3162277660f, 0.1778279410f, 0.1f, 0.05623413252f, 0.03162277660f, 0.01778279410f,
                                   0.01f, 0.005623413252f, 0.003162277660f, 0.001778279410f, 0.001f, 0.0005623413252f, 0.0003162277660f, 0.0001778279410f};

DI void gemm_in_tile(const Params& p, int l, int tile, unsigned char* lds) {
  const int tid = opaque_tid(), lane = tid & 63, w = tid >> 6, wr = w >> 1, wc = w & 1, r31 = lane & 31, hh = lane >> 5;
  const bool odd = l & 1; const int li = l >> 1;
  const int NTL = odd ? 20 : 28;
  const int mt = tile / NTL, nt = tile % NTL;
  const bool samp = mt >= 32;
  const bf16_t* A = (const bf16_t*)(p.ws + WS_H) + (size_t)mt * 128 * 1024;
  const bf16_t* B = (const bf16_t*)(p.ws + (odd ? WS_WIO : WS_WIE)) + (size_t)li * (odd ? 2560 : 3584) * 1024 + (size_t)nt * 128 * 1024;
  f32x16 acc[2][2];
  gemm_core(A, B, 1024, acc, lds);

  float* stage = (float*)lds;
  bf16_t* qkv = (bf16_t*)(p.ws + WS_QKV);
  int type = 0; bool do_silu = false, do_rope = false; const float* gnorm = nullptr; float* f32out = nullptr; int W = 128; int outcol = 0; int qstride;
  bf16_t* vtbase = nullptr; int ncv = 128, vcol0 = 0;
  if (!odd) {
    qstride = 3072;
    if (nt < 8) { type = 1; outcol = nt * 64; }
    else if (nt < 12) { do_silu = true; outcol = 512 + (nt - 8) * 128; }
    else if (nt < 16) { do_rope = samp; outcol = 1024 + (nt - 12) * 128; }
    else if (nt < 20) { do_rope = samp; outcol = 1536 + (nt - 16) * 128; W = 512; f32out = p.out + OFF_NBK + (size_t)li * 256 * 512 + (nt - 16) * 128; }
    else if (nt < 24) { type = 2; vtbase = (bf16_t*)(p.ws + WS_VT); ncv = 512; vcol0 = (nt - 20) * 128; W = 512; f32out = p.out + OFF_NBV + (size_t)li * 256 * 512 + (nt - 20) * 128; }
    else { do_silu = true; outcol = 2560 + (nt - 24) * 128; }
  } else {
    qstride = 2560; outcol = nt * 128;
    if (nt < 4) { gnorm = p.in[23] + li * 64; do_rope = samp; }
    else if (nt == 4) { gnorm = p.in[24] + li * 64; do_rope = samp; f32out = p.out + OFF_NCK + (size_t)li * 256 * 128; }
    else if (nt == 5) { type = 2; vtbase = (bf16_t*)(p.ws + WS_VT); f32out = p.out + OFF_NCV + (size_t)li * 256 * 128; }
    else if (nt < 10) { do_silu = true; }
    else if (nt < 14) { do_rope = samp; }
    else if (nt == 14) { do_rope = samp; f32out = p.out + OFF_NDK + (size_t)li * 256 * 128; }
    else if (nt == 15) { type = 2; vtbase = (bf16_t*)(p.ws + WS_VTD); f32out = p.out + OFF_NDV + (size_t)li * 256 * 128; }
    else { do_silu = true; }
  }
  if (samp) f32out = nullptr;

#pragma unroll 1
  for (int half = 0; half < 2; ++half) {
    __syncthreads();
    if (wr == half) {
#pragma unroll
      for (int mi = 0; mi < 2; ++mi)
#pragma unroll
        for (int ni = 0; ni < 2; ++ni)
#pragma unroll
          for (int i = 0; i < 16; ++i)
            stage[(mi * 32 + (i & 3) + 8 * (i >> 2) + 4 * hh) * 132 + wc * 64 + ni * 32 + r31] = acc[mi][ni][i];
    }
    __syncthreads();
    const int tokbase = mt * 128 + half * 64;
    const int row = tid >> 2, cc = tid & 3, tok = tokbase + row;
    if (type == 1) {
      float u[16], g[16];
#pragma unroll
      for (int j = 0; j < 4; ++j) {
        const f32x4 a = *(const f32x4*)(stage + row * 132 + cc * 16 + j * 4), b = *(const f32x4*)(stage + row * 132 + 64 + cc * 16 + j * 4);
#pragma unroll
        for (int e = 0; e < 4; ++e) { u[j * 4 + e] = a[e]; g[j * 4 + e] = b[e]; }
      }
      unsigned o[8];
#pragma unroll
      for (int j = 0; j < 8; ++j) o[j] = pk2(u[2 * j] * sigmoidf_(g[2 * j]), u[2 * j + 1] * sigmoidf_(g[2 * j + 1]));
      u32x4* d = (u32x4*)(qkv + (size_t)tok * 3072 + outcol + cc * 16);
      d[0] = (u32x4){o[0], o[1], o[2], o[3]}; d[1] = (u32x4){o[4], o[5], o[6], o[7]};
    } else {
      if (type == 0 || f32out) {
        float v[32];
#pragma unroll
        for (int j = 0; j < 8; ++j) {
          const f32x4 a = *(const f32x4*)(stage + row * 132 + cc * 32 + j * 4);
#pragma unroll
          for (int e = 0; e < 4; ++e) v[j * 4 + e] = a[e];
        }
        if (gnorm) {
          float ss = 0.f;
#pragma unroll
          for (int j = 0; j < 32; ++j) ss += v[j] * v[j];
          ss += __shfl_xor(ss, 1);
          const float rs = rsqrtf(ss * (1.0f / 64.0f) + EPS);
          const float* g = gnorm + (cc & 1) * 32;
#pragma unroll
          for (int j = 0; j < 32; ++j) v[j] *= rs * g[j];
        }
        if (f32out) {
          const int b = tok >> 8, s = tok & 255;
          float* o = f32out + ((size_t)b * 512 + s) * W + cc * 32;
#pragma unroll
          for (int j = 0; j < 8; ++j) *(f32x4*)(o + j * 4) = (f32x4){v[j * 4], v[j * 4 + 1], v[j * 4 + 2], v[j * 4 + 3]};
        }
        if (type == 0) {
          if (do_rope) {
            const int s = (tok - NP) & 1023;
            const float pos = (float)((cc & 1) ? (s & 63) : (s >> 6));
#pragma unroll
            for (int f = 0; f < 16; ++f) {
              const float ang = pos * INVF[f];
              const float sn = __sinf(ang), cs = __cosf(ang);
              const float x1 = v[f], x2 = v[16 + f];
              v[f] = x1 * cs - x2 * sn; v[16 + f] = x2 * cs + x1 * sn;
            }
          }
          if (do_silu) {
#pragma unroll
            for (int j = 0; j < 32; ++j) v[j] = v[j] * sigmoidf_(v[j]);
          }
          u32x4* d = (u32x4*)(qkv + (size_t)tok * qstride + outcol + cc * 32);
#pragma unroll
          for (int j = 0; j < 4; ++j) d[j] = (u32x4){pk2(v[j * 8], v[j * 8 + 1]), pk2(v[j * 8 + 2], v[j * 8 + 3]), pk2(v[j * 8 + 4], v[j * 8 + 5]), pk2(v[j * 8 + 6], v[j * 8 + 7])};
        }
      }
      if (type == 2) {
        const int c = tid & 127, rg = tid >> 7;
        unsigned o[16];
#pragma unroll
        for (int j = 0; j < 16; ++j) o[j] = pk2(stage[(rg * 32 + 2 * j) * 132 + c], stage[(rg * 32 + 2 * j + 1) * 132 + c]);
        const int t0 = tokbase + rg * 32;
        size_t idx;
        if (!samp) { const int b = t0 >> 8, s0 = t0 & 255; idx = ((size_t)b * ncv + vcol0 + c) * 256 + s0; }
        else { const int ts = t0 - NP, b = ts >> 10, s0 = ts & 1023; idx = (size_t)NP * ncv + ((size_t)b * ncv + vcol0 + c) * 1024 + s0; }
        u32x4* d = (u32x4*)(vtbase + idx);
#pragma unroll
        for (int j = 0; j < 4; ++j) {
          const int q0 = 4 * j;
          d[j] = (u32x4){o[(q0 & ~6) | ((q0 & 2) << 1) | ((q0 & 4) >> 1)], o[((q0 + 1) & ~6) | (((q0 + 1) & 2) << 1) | (((q0 + 1) & 4) >> 1)],
                         o[((q0 + 2) & ~6) | (((q0 + 2) & 2) << 1) | (((q0 + 2) & 4) >> 1)], o[((q0 + 3) & ~6) | (((q0 + 3) & 2) << 1) | (((q0 + 3) & 4) >> 1)]};
        }
      }
    }
  }
}

DI void gemm_out_tile(const Params& p, int l, int tile, unsigned char* lds) {
  const int tid = opaque_tid(), lane = tid & 63, w = tid >> 6, wr = w >> 1, wc = w & 1, r31 = lane & 31, hh = lane >> 5;
  const bool odd = l & 1; const int li = l >> 1;
  const int mt = tile >> 3, nt = tile & 7;
  const bf16_t* A = (const bf16_t*)(p.ws + WS_MIX) + (size_t)mt * 128 * 1024;
  const bf16_t* B = (const bf16_t*)(p.ws + (odd ? WS_WOO : WS_WOE)) + (size_t)li * 1024 * 1024 + (size_t)nt * 128 * 1024;
  f32x16 acc[2][2];
  gemm_core(A, B, 1024, acc, lds);
  float* stage = (float*)lds;
  bf16_t* O = (bf16_t*)(p.ws + WS_O);
#pragma unroll 1
  for (int half = 0; half < 2; ++half) {
    __syncthreads();
    if (wr == half) {
#pragma unroll
      for (int mi = 0; mi < 2; ++mi)
#pragma unroll
        for (int ni = 0; ni < 2; ++ni)
#pragma unroll
          for (int i = 0; i < 16; ++i)
            stage[(mi * 32 + (i & 3) + 8 * (i >> 2) + 4 * hh) * 132 + wc * 64 + ni * 32 + r31] = acc[mi][ni][i];
    }
    __syncthreads();
    const int row = tid >> 2, cc = tid & 3;
    float v[32];
#pragma unroll
    for (int j = 0; j < 8; ++j) {
      const f32x4 a = *(const f32x4*)(stage + row * 132 + cc * 32 + j * 4);
#pragma unroll
      for (int e = 0; e < 4; ++e) v[j * 4 + e] = a[e];
    }
    u32x4* d = (u32x4*)(O + (size_t)(mt * 128 + half * 64 + row) * 1024 + nt * 128 + cc * 32);
#pragma unroll
    for (int j = 0; j < 4; ++j) d[j] = (u32x4){pk2(v[j * 8], v[j * 8 + 1]), pk2(v[j * 8 + 2], v[j * 8 + 3]), pk2(v[j * 8 + 4], v[j * 8 + 5]), pk2(v[j * 8 + 6], v[j * 8 + 7])};
  }
}

template <int MODE, int KS>
DI void attn_task(const Params& p, int l, int kind, int b, int head, int qt, int sub, int rotn, int rotd, unsigned char* lds) {
  constexpr int NKC = MODE == 0 ? 2 : 1;
  constexpr int DV = MODE == 0 ? 128 : 64;
  constexpr int NT = DV / 32;
  constexpr int NKT = KS ? 1 : 2;
  constexpr int NG = KS ? 2 : 4;
  constexpr int KCH = NKC * 2;
  constexpr int VCH = DV / 32;
  constexpr int VOFF = NKC * 8192;
  constexpr int STAGE = VOFF + DV * 128;
  constexpr float SC = 0.18033688011112042f;
  constexpr float DEFER_RAW = 8.0f / SC;
  const int tid = opaque_tid(), lane = tid & 63, w = tid >> 6, r31 = lane & 31, hh = lane >> 5;
  const int kh = KS ? (w & 1) : 0;
  const int hq = (MODE == 1) ? (KS ? head * 4 + sub * 2 + (w >> 1) : head * 4 + w) : 0;
  const int li = l >> 1;
  const bf16_t* qkv = (const bf16_t*)(p.ws + WS_QKV);
  bf16_t* mix = (bf16_t*)(p.ws + WS_MIX);
  bool samp, isD = false; int q0, tok0, T;
  const bf16_t *k0p = nullptr, *k1p, *v0p = nullptr, *v1p; int ks0 = 0, ks1, vs0 = 0, vs1;
  int nt0 = 0, t1lo = 0, t1hi; bool windowed = false, has_sink = false; float sinkv = 0.f;
  if (MODE == 0) {
    samp = (kind == 0);
    q0 = qt * (KS ? 32 : 64);
    if (samp) { tok0 = NP + b * 1024; T = 1024; } else { tok0 = b * 256; T = 256; }
    k1p = qkv + (size_t)tok0 * 3072 + 1536 + head * 128; ks1 = 3072;
    const bf16_t* vt = (const bf16_t*)(p.ws + WS_VT);
    v1p = vt + (samp ? (size_t)NP * 512 + ((size_t)b * 512 + head * 128) * 1024 : ((size_t)b * 512 + head * 128) * 256); vs1 = T;
    t1hi = T >> 6;
    if (samp) {
      nt0 = 8;
      k0p = (const bf16_t*)(p.ws + WS_CBK) + ((size_t)(b * 2 + li) * 512) * 512 + head * 128; ks0 = 512;
      v0p = (const bf16_t*)(p.ws + WS_CBV) + ((size_t)(b * 2 + li) * 512 + head * 128) * 512; vs0 = 512;
    }
  } else {
    isD = kind & 1; samp = kind < 2;
    q0 = qt * 32;
    if (samp) { tok0 = NP + b * 1024; T = 1024; } else { tok0 = b * 256; T = 256; }
    k1p = qkv + (size_t)tok0 * 2560 + (isD ? 1792 : 512) + head * 64; ks1 = 2560;
    const bf16_t* vt = (const bf16_t*)(p.ws + (isD ? WS_VTD : WS_VT));
    v1p = vt + (samp ? (size_t)NP * 128 + ((size_t)b * 128 + head * 64) * 1024 : ((size_t)b * 128 + head * 64) * 256); vs1 = T;
    t1hi = T >> 6;
    if (samp) {
      nt0 = 8;
      k0p = (const bf16_t*)(p.ws + (isD ? WS_CDK : WS_CCK)) + ((size_t)(b * 2 + li) * 512) * 128 + head * 64; ks0 = 128;
      v0p = (const bf16_t*)(p.ws + (isD ? WS_CDV : WS_CCV)) + ((size_t)(b * 2 + li) * 128 + head * 64) * 512; vs0 = 512;
    }
    if (isD) {
      has_sink = true; sinkv = p.in[25][li * 8 + hq];
      if (samp) { windowed = true; const int lo = q0 - 128, hi = q0 + 159; t1lo = (lo < 0 ? 0 : lo) >> 6; t1hi = ((hi > 1023 ? 1023 : hi) >> 6) + 1; }
    }
  }
  const int qrow = (MODE == 0 && !KS) ? q0 + 32 * (w & 1) + r31 : q0 + r31;
  const bf16_t* qp = (MODE == 0) ? qkv + (size_t)(tok0 + qrow) * 3072 + 1024 + head * 128 + (w >> 1) * 64
                                 : qkv + (size_t)(tok0 + qrow) * 2560 + (isD ? 1280 : 0) + hq * 64;
  bf16x8 qf[4];
#pragma unroll
  for (int ks = 0; ks < 4; ++ks) qf[ks] = *(const bf16x8*)(qp + ks * 16 + hh * 8);
  const int koff = (MODE == 0) ? (w >> 1) * 8192 : 0;
  const int nst = nt0 + (t1hi - t1lo);
  const int rot = (rotn * nst) / rotd;
  const int swz = (r31 >> 1) & 7;

  u32x4 rk[KCH], rv[VCH];
  auto gload = [&](int i) {
    int st = i + rot; if (st >= nst) st -= nst;
    const bf16_t* kp; int kst; const bf16_t* vp; int vst; int key0;
    if (st < nt0) { kp = k0p; kst = ks0; vp = v0p; vst = vs0; key0 = st * 64; }
    else { kp = k1p; kst = ks1; vp = v1p; vst = vs1; key0 = (t1lo + st - nt0) * 64; }
#pragma unroll
    for (int j = 0; j < KCH; ++j) {
      const int c = tid + 256 * j;
      const int key = (NKC == 2) ? (c >> 4) : (c >> 3), cc = (NKC == 2) ? (c & 15) : (c & 7);
      rk[j] = *(const u32x4*)(kp + (size_t)(key0 + key) * kst + cc * 8);
    }
#pragma unroll
    for (int j = 0; j < VCH; ++j) {
      const int c = tid + 256 * j, dv = c >> 3, ch = c & 7;
      rv[j] = *(const u32x4*)(vp + (size_t)dv * vst + key0 + ch * 8);
    }
  };
  auto lstore = [&](int buf) {
    unsigned char* base = lds + buf * STAGE;
#pragma unroll
    for (int j = 0; j < KCH; ++j) {
      const int c = tid + 256 * j;
      const int key = (NKC == 2) ? (c >> 4) : (c >> 3), cc = (NKC == 2) ? (c & 15) : (c & 7);
      const int sub = cc >> 3, ch = cc & 7;
      *(u32x4*)(base + sub * 8192 + key * 128 + ((ch ^ ((key >> 1) & 7)) << 4)) = rk[j];
    }
#pragma unroll
    for (int j = 0; j < VCH; ++j) {
      const int c = tid + 256 * j, dv = c >> 3, ch = c & 7;
      *(u32x4*)(base + VOFF + dv * 128 + ((ch ^ ((dv >> 1) & 7)) << 4)) = rv[j];
    }
  };

  f32x16 O[NT];
#pragma unroll
  for (int t = 0; t < NT; ++t)
#pragma unroll
    for (int i = 0; i < 16; ++i) O[t][i] = 0.f;
  float m = has_sink ? sinkv * 8.0f : -1e30f;
  float lsum = (has_sink && hh == 0 && kh == 0) ? 1.0f : 0.f;

  __syncthreads();
  gload(0); lstore(0);
  if (nst > 1) gload(1);
  __syncthreads();
  for (int it = 0; it < nst; ++it) {
    if (it + 1 < nst) lstore((it + 1) & 1);
    if (it + 2 < nst) gload(it + 2);
    __builtin_amdgcn_sched_barrier(0);
    const unsigned char* ksub = lds + (it & 1) * STAGE + koff;
    const unsigned char* vsub = lds + (it & 1) * STAGE + VOFF;
    f32x16 s[NKT];
    {
      bf16x8 kf[NKT][4];
#pragma unroll
      for (int ks = 0; ks < 4; ++ks)
#pragma unroll
        for (int kt = 0; kt < NKT; ++kt) kf[kt][ks] = *(const bf16x8*)(ksub + ((KS ? kh : kt) * 32 + r31) * 128 + (((ks * 2 + hh) ^ swz) << 4));
      __builtin_amdgcn_sched_barrier(0);
      __builtin_amdgcn_s_setprio(1);
#pragma unroll
      for (int kt = 0; kt < NKT; ++kt)
#pragma unroll
        for (int i = 0; i < 16; ++i) s[kt][i] = 0.f;
#pragma unroll
      for (int ks = 0; ks < 4; ++ks)
#pragma unroll
        for (int kt = 0; kt < NKT; ++kt) s[kt] = mfma32(kf[kt][ks], qf[ks], s[kt]);
      __builtin_amdgcn_s_setprio(0);
    }
    bf16x8 vf[2][NT];
#pragma unroll
    for (int t = 0; t < NT; ++t) vf[0][t] = *(const bf16x8*)(vsub + (t * 32 + r31) * 128 + (((kh * 4 + hh) ^ swz) << 4));
    if (MODE == 1 && windowed) {
      int st = it + rot; if (st >= nst) st -= nst;
      if (st >= nt0) {
        const int key0 = (t1lo + st - nt0) * 64, qpos = q0 + r31;
#pragma unroll
        for (int kt = 0; kt < NKT; ++kt)
#pragma unroll
          for (int i = 0; i < 16; ++i) {
            const int kpos = key0 + (KS ? kh : kt) * 32 + (i & 3) + 8 * (i >> 2) + 4 * hh;
            const int d = qpos - kpos;
            if (d > 128 || d < -128) s[kt][i] = -1e30f;
          }
      }
    }
    float mx = s[0][0];
#pragma unroll
    for (int kt = 0; kt < NKT; ++kt)
#pragma unroll
      for (int i = 0; i < 16; ++i) mx = fmaxf(mx, s[kt][i]);
    { const auto sw = __builtin_amdgcn_permlane32_swap(__float_as_uint(mx), __float_as_uint(mx), false, false);
      mx = fmaxf(__uint_as_float(sw[0]), __uint_as_float(sw[1])); }
    if (__any(mx > m + DEFER_RAW)) {
      const float mnew = fmaxf(m, mx);
      const float alpha = __builtin_amdgcn_exp2f((m - mnew) * SC);
      m = mnew;
      lsum *= alpha;
#pragma unroll
      for (int t = 0; t < NT; ++t)
#pragma unroll
        for (int i = 0; i < 16; ++i) O[t][i] *= alpha;
    }
    const float mc = m * SC;
    f32x2 ps2 = {0.f, 0.f};
#pragma unroll
    for (int kt = 0; kt < NKT; ++kt)
#pragma unroll
      for (int i = 0; i < 16; i += 2) {
        const f32x2 sv = {s[kt][i], s[kt][i + 1]};
        const f32x2 tv = sv * SC - mc;
        f32x2 ev; ev.x = __builtin_amdgcn_exp2f(tv.x); ev.y = __builtin_amdgcn_exp2f(tv.y);
        s[kt][i] = ev.x; s[kt][i + 1] = ev.y;
        ps2 += ev;
      }
    lsum += ps2.x + ps2.y;
#pragma unroll
    for (int g = 0; g < NG; ++g) {
      const int kt = KS ? 0 : (g >> 1), sx = g & 1;
      if (g < NG - 1) {
#pragma unroll
        for (int t = 0; t < NT; ++t) vf[(g + 1) & 1][t] = *(const bf16x8*)(vsub + (t * 32 + r31) * 128 + ((((kh * 2 + g + 1) * 2 + hh) ^ swz) << 4));
      }
      __builtin_amdgcn_sched_barrier(0);
      u32x4 pw = {pk2(s[kt][8 * sx + 0], s[kt][8 * sx + 1]), pk2(s[kt][8 * sx + 2], s[kt][8 * sx + 3]),
                  pk2(s[kt][8 * sx + 4], s[kt][8 * sx + 5]), pk2(s[kt][8 * sx + 6], s[kt][8 * sx + 7])};
      const bf16x8 pf = __builtin_bit_cast(bf16x8, pw);
#pragma unroll
      for (int t = 0; t < NT; ++t) O[t] = mfma32(vf[g & 1][t], pf, O[t]);
      __builtin_amdgcn_sched_barrier(0);
    }
    __syncthreads();
  }
  float* X = (float*)lds;
  if (KS) {
    constexpr int RS = NT * 16 + 2;
    const int pi = w >> 1;
    if (kh == 1) {
#pragma unroll
      for (int t = 0; t < NT; ++t)
#pragma unroll
        for (int i = 0; i < 16; ++i) X[((pi * RS + t * 16 + i) << 6) + lane] = O[t][i];
      X[((pi * RS + NT * 16) << 6) + lane] = m;
      X[((pi * RS + NT * 16 + 1) << 6) + lane] = lsum;
    }
    __syncthreads();
    if (kh == 0) {
      const float m1 = X[((pi * RS + NT * 16) << 6) + lane], l1 = X[((pi * RS + NT * 16 + 1) << 6) + lane];
      const float mm = fmaxf(m, m1);
      const float a0 = __builtin_amdgcn_exp2f((m - mm) * SC), a1 = __builtin_amdgcn_exp2f((m1 - mm) * SC);
#pragma unroll
      for (int t = 0; t < NT; ++t)
#pragma unroll
        for (int i = 0; i < 16; ++i) O[t][i] = O[t][i] * a0 + X[((pi * RS + t * 16 + i) << 6) + lane] * a1;
      lsum = lsum * a0 + l1 * a1;
    }
    __syncthreads();
  }
  const float ltot = lsum + __shfl_xor(lsum, 32);
  const float inv = 1.0f / ltot;
  const int tok = tok0 + qrow;
  if (MODE == 1) {
    if (kh == 0) {
      const bf16_t* zp = qkv + (size_t)tok * 2560 + (isD ? 2048 : 768) + hq * 64;
      bf16_t* op = mix + (size_t)tok * 1024 + (isD ? 512 : 0) + hq * 64;
#pragma unroll
      for (int t = 0; t < NT; ++t)
#pragma unroll
        for (int i4 = 0; i4 < 4; ++i4) {
          const int dv0 = t * 32 + 8 * i4 + 4 * hh;
          const u32x2 z = *(const u32x2*)(zp + dv0);
          u32x2 o = {pk2(O[t][4 * i4] * inv * bf_lo(z[0]), O[t][4 * i4 + 1] * inv * bf_hi(z[0])),
                     pk2(O[t][4 * i4 + 2] * inv * bf_lo(z[1]), O[t][4 * i4 + 3] * inv * bf_hi(z[1]))};
          *(u32x2*)(op + dv0) = o;
        }
    }
  } else {
    const float* lv = p.in[19] + li * 256;
    float d1 = wave_sum(lv[lane] * lv[64 + lane]), d2 = wave_sum(lv[128 + lane] * lv[192 + lane]);
    const float lam_init = (l == 0) ? 0.2f : 0.47071301834358416f;
    const float lam = expf(d1) - expf(d2) + lam_init;
    const int xr = KS ? 0 : (w & 1) * 64;
    if (w >= 2 && kh == 0) {
#pragma unroll
      for (int t = 0; t < NT; ++t)
#pragma unroll
        for (int i = 0; i < 16; ++i) X[((xr + t * 16 + i) << 6) + lane] = O[t][i] * inv;
    }
    __syncthreads();
    if (w < 2 && kh == 0) {
      float ss = 0.f;
#pragma unroll
      for (int t = 0; t < NT; ++t)
#pragma unroll
        for (int i = 0; i < 16; ++i) { const float o = O[t][i] * inv - lam * X[((xr + t * 16 + i) << 6) + lane]; O[t][i] = o; ss += o * o; }
      ss += __shfl_xor(ss, 32);
      const float scale = rsqrtf(ss * (1.0f / 128.0f) + EPS) * (1.0f - lam_init);
      const float* sg = p.in[20] + li * 128;
      const bf16_t* zp = qkv + (size_t)tok * 3072 + 2560 + head * 128;
      bf16_t* op = mix + (size_t)tok * 1024 + 512 + head * 128;
#pragma unroll
      for (int t = 0; t < NT; ++t)
#pragma unroll
        for (int i4 = 0; i4 < 4; ++i4) {
          const int dv0 = t * 32 + 8 * i4 + 4 * hh;
          const u32x2 z = *(const u32x2*)(zp + dv0);
          const f32x4 g = *(const f32x4*)(sg + dv0);
          u32x2 o = {pk2(O[t][4 * i4] * scale * g[0] * bf_lo(z[0]), O[t][4 * i4 + 1] * scale * g[1] * bf_hi(z[0])),
                     pk2(O[t][4 * i4 + 2] * scale * g[2] * bf_lo(z[1]), O[t][4 * i4 + 3] * scale * g[3] * bf_hi(z[1]))};
          *(u32x2*)(op + dv0) = o;
        }
    }
  }
}

DI void conv_task(const Params& p, int l, int tile, unsigned char* lds) {
  const int tid = opaque_tid(), lane = tid & 63, w = tid >> 6;
  const int li = l >> 1;
  const bf16_t* qkv = (const bf16_t*)(p.ws + WS_QKV);
  bf16_t* mix = (bf16_t*)(p.ws + WS_MIX);
  const int t0 = tile * 32;
  const int seq_lo = t0 < NP ? (t0 & ~255) : NP + ((t0 - NP) & ~1023);
  const int seq_hi = seq_lo + (t0 < NP ? 256 : 1024);
  __syncthreads();
  {
    u32x4 v[16];
#pragma unroll
    for (int i = 0; i < 16; ++i) {
      const int c = tid + 256 * i, rr = c >> 6, ch = c & 63, tk = t0 - 15 + rr;
      v[i] = (u32x4){0u, 0u, 0u, 0u};
      if (c < 62 * 64 && tk >= seq_lo && tk < seq_hi) v[i] = *(const u32x4*)(qkv + (size_t)tk * 3072 + ch * 8);
    }
#pragma unroll
    for (int i = 0; i < 16; ++i) {
      const int c = tid + 256 * i, rr = c >> 6, ch = c & 63;
      if (c < 62 * 64) *(u32x4*)(lds + rr * 1024 + ch * 16) = v[i];
    }
  }
  __syncthreads();
  const float* cw = p.in[15] + (size_t)li * 31 * 512;
  const float* cb = p.in[16] + li * 512;
  const float* lg = p.in[17] + li * 512;
  const float* lb = p.in[18] + li * 512;
  float sum[8], sq[8];
#pragma unroll
  for (int tt = 0; tt < 8; ++tt) { sum[tt] = 0.f; sq[tt] = 0.f; }
#pragma unroll 1
  for (int pz = 0; pz < 4; ++pz) {
    const int ch = pz * 128 + lane * 2;
    f32x2 wv[31];
#pragma unroll
    for (int j = 0; j < 31; ++j) wv[j] = *(const f32x2*)(cw + j * 512 + ch);
    const f32x2 bias = *(const f32x2*)(cb + ch);
    float r[8][2];
#pragma unroll
    for (int tt = 0; tt < 8; ++tt) { r[tt][0] = bias[0]; r[tt][1] = bias[1]; }
#pragma unroll
    for (int rr = 0; rr < 38; ++rr) {
      const unsigned xv = *(const unsigned*)(lds + (w * 8 + rr) * 1024 + ch * 2);
      const float x0 = bf_lo(xv), x1 = bf_hi(xv);
#pragma unroll
      for (int tt = 0; tt < 8; ++tt) {
        const int j = rr - tt;
        if (j >= 0 && j < 31) { r[tt][0] += wv[j][0] * x0; r[tt][1] += wv[j][1] * x1; }
      }
    }
#pragma unroll
    for (int tt = 0; tt < 8; ++tt) {
      sum[tt] += r[tt][0] + r[tt][1]; sq[tt] += r[tt][0] * r[tt][0] + r[tt][1] * r[tt][1];
      *(unsigned*)(mix + (size_t)(t0 + w * 8 + tt) * 1024 + ch) = pk2(r[tt][0], r[tt][1]);
    }
  }
#pragma unroll
  for (int tt = 0; tt < 8; ++tt) {
    const float mu = wave_sum(sum[tt]) * (1.0f / 512.0f);
    const float var = wave_sum(sq[tt]) * (1.0f / 512.0f) - mu * mu;
    sum[tt] = mu; sq[tt] = rsqrtf(fmaxf(var, 0.f) + EPS);
  }
#pragma unroll 1
  for (int pz = 0; pz < 4; ++pz) {
    const int ch = pz * 128 + lane * 2;
    const f32x2 g = *(const f32x2*)(lg + ch), bb = *(const f32x2*)(lb + ch);
    unsigned rv[8], zv[8];
#pragma unroll
    for (int tt = 0; tt < 8; ++tt) {
      const int tok = t0 + w * 8 + tt;
      rv[tt] = *(const unsigned*)(mix + (size_t)tok * 1024 + ch);
      zv[tt] = *(const unsigned*)(qkv + (size_t)tok * 3072 + 512 + ch);
    }
#pragma unroll
    for (int tt = 0; tt < 8; ++tt) {
      const int tok = t0 + w * 8 + tt;
      float y0 = (bf_lo(rv[tt]) - sum[tt]) * sq[tt] * g[0] + bb[0], y1 = (bf_hi(rv[tt]) - sum[tt]) * sq[tt] * g[1] + bb[1];
      y0 = y0 * sigmoidf_(y0) * bf_lo(zv[tt]); y1 = y1 * sigmoidf_(y1) * bf_hi(zv[tt]);
      *(unsigned*)(mix + (size_t)tok * 1024 + ch) = pk2(y0, y1);
    }
  }
}

DI void phase_mix(const Params& p, int l, unsigned char* lds) {
  const bool odd = l & 1;
  const int ntask = odd ? 768 : 704;
  const int G = gridDim.x, bid = blockIdx.x;
  for (int r = 0;; ++r) {
    if (r * G >= ntask) break;
    const int t = r * G + ((r & 1) ? (G - 1 - bid) : bid);
    if (t >= ntask) continue;
    if (!odd) {
      if (t < 256) { const int x = t & 7, j = t >> 3; attn_task<0, 1>(p, l, 0, x >> 2, x & 3, j, 0, j, 32, lds); }
      else if (t < 448) conv_task(p, l, t - 256, lds);
      else { const int u = t - 448, x = u & 7, j = u >> 3, sm = (j >> 2) * 8 + x; attn_task<0, 0>(p, l, 1, sm >> 2, sm & 3, j & 3, 0, j & 3, 4, lds); }
    } else {
      if (t < 256) { const int u = t & 127, x = u & 7, j = u >> 3, sm = x & 3; attn_task<1, 0>(p, l, t >> 7, sm >> 1, sm & 1, (x >> 2) * 16 + j, 0, j, 16, lds); }
      else { const int u = (t - 256) & 255, x = u & 7, j = u >> 3, sm = (j >> 3) * 8 + x; attn_task<1, 0>(p, l, 2 + ((t - 256) >> 8), sm >> 1, sm & 1, j & 7, 0, j & 7, 8, lds); }
    }
  }
}

constexpr int LDS_BYTES = 65536 + 64;
__global__ void __launch_bounds__(256, 2) mega(Params p, int ph_lo, int ph_hi) {
  extern __shared__ __attribute__((aligned(16))) unsigned char lds[];
  cg::grid_group grid = cg::this_grid();
  if (ph_lo > 1000) grid.sync();
  volatile LAS unsigned* st = (volatile LAS unsigned*)(lds + 65536);
  if (threadIdx.x == 0) { st[0] = 0u; st[1] = 0u; }
  __syncthreads();
  const XcdBarrier xb = xcd_barrier_post((unsigned*)(p.ws + WS_BAR), st);
  for (int ph = ph_lo; ph < ph_hi; ++ph) {
    if (ph == 0) phase_prep(p, lds);
    else if (ph == 1) phase_post(p, -1, 0);
    else {
      const int l = (ph - 2) >> 2, sub = (ph - 2) & 3;
      if (sub == 0) { const int nt = (l & 1) ? 48 * 20 : 48 * 28; for (int t = blockIdx.x; t < nt; t += gridDim.x) gemm_in_tile(p, l, t, lds); }
      else if (sub == 1) phase_mix(p, l, lds);
      else if (sub == 2) { for (int t = blockIdx.x; t < 384; t += gridDim.x) gemm_out_tile(p, l, t, lds); }
      else phase_post(p, l, l + 1);
    }
    if (ph + 1 < ph_hi) xcd_barrier(xb);
  }
}

#ifndef PER_PHASE_LAUNCH
#define PER_PHASE_LAUNCH 0
#endif

extern "C" void kernel_launch(void* const* d_in, const int* in_sizes, int n_in, void* d_out, int out_size, void* d_ws, size_t ws_size, hipStream_t stream) {
  static int grid_blocks = 0;
  if (!grid_blocks) {
    int dev = 0, cus = 0, per_cu = 0;
    (void)hipGetDevice(&dev);
    (void)hipDeviceGetAttribute(&cus, hipDeviceAttributeMultiprocessorCount, dev);
    (void)hipFuncSetAttribute((const void*)mega, hipFuncAttributeMaxDynamicSharedMemorySize, LDS_BYTES);
    (void)hipOccupancyMaxActiveBlocksPerMultiprocessor(&per_cu, mega, 256, LDS_BYTES);
    if (per_cu < 1) per_cu = 1;
    if (per_cu > 2) per_cu = 2;
    grid_blocks = cus * per_cu;
    if (n_in != 27 || ws_size < WS_END) fprintf(stderr, "kernel_launch: unexpected n_in %d / ws %zu\n", n_in, ws_size);
  }
  (void)hipMemsetAsync(d_ws, 0, 16384, stream);
  Params p{};
  for (int i = 0; i < 27; ++i) p.in[i] = (const float*)d_in[i];
  p.out = (float*)d_out; p.ws = (unsigned char*)d_ws;
#if PER_PHASE_LAUNCH
  for (int ph = 0; ph < NPHASE; ++ph) hipLaunchKernelGGL(mega, dim3(grid_blocks), dim3(256), LDS_BYTES, stream, p, ph, ph + 1);
#else
  int lo = 0, hi = NPHASE;
  void* args[] = {&p, &lo, &hi};
  hipError_t e = hipLaunchCooperativeKernel((void*)mega, dim3(grid_blocks), dim3(256), args, LDS_BYTES, stream);
  if (e != hipSuccess) fprintf(stderr, "cooperative launch failed: %s (grid %d)\n", hipGetErrorString(e), grid_blocks);
#endif
}
```
